# Optimizing an MI355X kernel written in HIP

```python
import jax, jax.numpy as jnp
from jax import lax
import numpy as np

D_MODEL = 2048
BATCH = 2
SEQ = 16384
DEPTH = 1

GLA_HEADS = 4
GLA_DK = D_MODEL // 2 // GLA_HEADS
GLA_DV = D_MODEL // GLA_HEADS
GLA_GATE_RANK = 16
GLA_TAU = 16.0
GLA_CHUNK = 64

SWA_HEADS = 32
SWA_KV_HEADS = 4
SWA_HEAD_DIM = 64
SWA_GROUP = SWA_HEADS // SWA_KV_HEADS
WINDOW = 128

D_FF = 4 * D_MODEL

DEEPNORM_ALPHA = (2.0 * DEPTH) ** 0.25
DEEPNORM_BETA = (8.0 * DEPTH) ** -0.25
LN_EPS = 1e-5
RMS_EPS = 1e-6

SPLITS = (
    GLA_HEADS * GLA_DK,
    GLA_HEADS * GLA_DK,
    GLA_HEADS * GLA_DV,
    GLA_HEADS * GLA_DV,
    GLA_GATE_RANK,
    SWA_HEADS * SWA_HEAD_DIM,
    SWA_KV_HEADS * SWA_HEAD_DIM,
    SWA_KV_HEADS * SWA_HEAD_DIM,
    D_MODEL,
    D_MODEL,
)
V_SEGMENTS = (2, 7)

kernel_name = "hybrid_gla_swa_deepnorm_layer"


def layer_norm(x, g, b):
    xf = x.astype(jnp.float32)
    mu = jnp.mean(xf, axis=-1, keepdims=True)
    var = jnp.mean(jnp.square(xf - mu), axis=-1, keepdims=True)
    y = (xf - mu) * lax.rsqrt(var + LN_EPS) * g.astype(jnp.float32) + b.astype(jnp.float32)
    return y.astype(x.dtype)


def alibi_slopes(n_heads):
    h = np.arange(1, n_heads + 1, dtype=np.float32)
    return jnp.asarray(2.0 ** (-8.0 * h / n_heads), dtype=jnp.float32)


def gla_chunked(q, k, v, log_a):
    B, S, H, DK = q.shape
    DV = v.shape[-1]
    C = GLA_CHUNK
    nc = S // C
    q = q.reshape(B, nc, C, H, DK)
    k = k.reshape(B, nc, C, H, DK)
    v = v.reshape(B, nc, C, H, DV)
    b = jnp.cumsum(log_a.reshape(B, nc, C, H, DK), axis=2)
    b_last = b[:, :, -1]
    q_in = q * jnp.exp(b)
    k_in = k * jnp.exp(-b)
    k_dec = k * jnp.exp(b_last[:, :, None] - b)
    decay = jnp.exp(b_last)
    causal = jnp.tril(jnp.ones((C, C), dtype=bool))
    scores = jnp.einsum('bnqhd,bnshd->bnhqs', q_in, k_in)
    scores = jnp.where(causal, scores, 0.0)
    o_intra = jnp.einsum('bnhqs,bnshv->bnqhv', scores, v)

    def step(state, xs):
        qc, kc, vc, dc = xs
        o = jnp.einsum('bqhd,bhdv->bqhv', qc, state)
        state = dc[..., None] * state + jnp.einsum('bshd,bshv->bhdv', kc, vc)
        return state, o

    xs = (jnp.moveaxis(q_in, 1, 0), jnp.moveaxis(k_dec, 1, 0),
          jnp.moveaxis(v, 1, 0), jnp.moveaxis(decay, 1, 0))
    state0 = jnp.zeros((B, H, DK, DV), dtype=q.dtype)
    _, o_inter = lax.scan(step, state0, xs)
    o = o_intra + jnp.moveaxis(o_inter, 0, 1)
    return o.reshape(B, S, H, DV)


def swa_banded(q, k, v, sinks):
    B, S, H, hd = q.shape
    W = WINDOW
    nb = S // W
    qb = q.reshape(B, nb, W, SWA_KV_HEADS, SWA_GROUP, hd)
    pad = ((0, 0), (W, 0), (0, 0), (0, 0))
    kp = jnp.pad(k, pad).reshape(B, nb + 1, W, SWA_KV_HEADS, hd)
    vp = jnp.pad(v, pad).reshape(B, nb + 1, W, SWA_KV_HEADS, hd)
    kb = jnp.concatenate([kp[:, :-1], kp[:, 1:]], axis=2)
    vb = jnp.concatenate([vp[:, :-1], vp[:, 1:]], axis=2)
    logits = jnp.einsum('bnqkgd,bnskd->bnkgqs', qb, kb).astype(jnp.float32) * (hd ** -0.5)
    qi = jnp.arange(W)[:, None]
    sj = jnp.arange(2 * W)[None, :]
    dist = qi - sj + W
    blk = jnp.arange(nb)[:, None, None]
    valid = (dist >= 0) & (dist < W) & (blk * W + sj - W >= 0)
    slopes = alibi_slopes(SWA_HEADS).reshape(SWA_KV_HEADS, SWA_GROUP)
    logits = logits - slopes[:, :, None, None] * dist.astype(jnp.float32)
    logits = jnp.where(valid[None, :, None, None], logits, jnp.finfo(jnp.float32).min)
    sink = sinks.astype(jnp.float32).reshape(SWA_KV_HEADS, SWA_GROUP)[None, None, :, :, None, None]
    m = jnp.maximum(jnp.max(logits, axis=-1, keepdims=True), sink)
    p = jnp.exp(logits - m)
    probs = p / (jnp.sum(p, axis=-1, keepdims=True) + jnp.exp(sink - m))
    o = jnp.einsum('bnkgqs,bnskd->bnqkgd', probs.astype(v.dtype), vb)
    return o.reshape(B, S, H * hd)


def setup_inputs(seed: int = 0) -> dict:
    key = jax.random.key(seed)
    ks = jax.random.split(key, 16)
    f32 = jnp.float32
    n_in = int(sum(SPLITS))
    col_scale = np.concatenate([
        np.full((s,), DEEPNORM_BETA if i in V_SEGMENTS else 1.0, dtype=np.float32)
        for i, s in enumerate(SPLITS)])
    x = jax.random.normal(ks[0], (BATCH, SEQ, D_MODEL), f32)
    w_in = jax.random.normal(ks[1], (D_MODEL, n_in), f32) * (D_MODEL ** -0.5) * jnp.asarray(col_scale)
    w_alpha_up = jax.random.normal(ks[2], (GLA_GATE_RANK, GLA_HEADS * GLA_DK), f32) * (GLA_GATE_RANK ** -0.5)
    b_alpha = 0.1 * jax.random.normal(ks[3], (GLA_HEADS * GLA_DK,), f32)
    gla_norm_w = 1.0 + 0.02 * jax.random.normal(ks[4], (GLA_DV,), f32)
    attn_sinks = 0.5 * jax.random.normal(ks[5], (SWA_HEADS,), f32)
    w_branch_gla = jax.random.normal(ks[6], (GLA_HEADS * GLA_DV, D_MODEL), f32) * ((GLA_HEADS * GLA_DV) ** -0.5) * DEEPNORM_BETA
    w_branch_swa = jax.random.normal(ks[7], (SWA_HEADS * SWA_HEAD_DIM, D_MODEL), f32) * ((SWA_HEADS * SWA_HEAD_DIM) ** -0.5) * DEEPNORM_BETA
    w_out = jax.random.normal(ks[8], (D_MODEL, D_MODEL), f32) * (D_MODEL ** -0.5) * DEEPNORM_BETA
    ln1_g = 1.0 + 0.02 * jax.random.normal(ks[9], (D_MODEL,), f32)
    ln1_b = 0.02 * jax.random.normal(ks[10], (D_MODEL,), f32)
    w_ff_up = jax.random.normal(ks[11], (D_MODEL, D_FF), f32) * (D_MODEL ** -0.5)
    w_ff_down = jax.random.normal(ks[12], (D_FF, D_MODEL), f32) * (D_FF ** -0.5) * DEEPNORM_BETA
    ln2_g = 1.0 + 0.02 * jax.random.normal(ks[13], (D_MODEL,), f32)
    ln2_b = 0.02 * jax.random.normal(ks[14], (D_MODEL,), f32)
    return {"x": x, "w_in": w_in, "w_alpha_up": w_alpha_up, "b_alpha": b_alpha,
            "gla_norm_w": gla_norm_w, "attn_sinks": attn_sinks,
            "w_branch_gla": w_branch_gla, "w_branch_swa": w_branch_swa, "w_out": w_out,
            "ln1_g": ln1_g, "ln1_b": ln1_b, "w_ff_up": w_ff_up, "w_ff_down": w_ff_down,
            "ln2_g": ln2_g, "ln2_b": ln2_b}


def reference(x, w_in, w_alpha_up, b_alpha, gla_norm_w, attn_sinks, w_branch_gla,
              w_branch_swa, w_out, ln1_g, ln1_b, w_ff_up, w_ff_down, ln2_g, ln2_b):
    B, S, _ = x.shape
    f32 = jnp.float32
    offsets = [int(o) for o in np.cumsum(SPLITS)[:-1]]
    for _layer in range(DEPTH):
        proj = x @ w_in
        (g_q, g_k, g_v, g_out, g_lr, s_q, s_k, s_v,
         gate_gla, gate_swa) = jnp.split(proj, offsets, axis=-1)

        log_a = jax.nn.log_sigmoid((g_lr @ w_alpha_up + b_alpha).astype(f32)) / GLA_TAU
        q_a = g_q.astype(f32).reshape(B, S, GLA_HEADS, GLA_DK) * (GLA_DK ** -0.5)
        k_a = g_k.astype(f32).reshape(B, S, GLA_HEADS, GLA_DK)
        v_a = g_v.astype(f32).reshape(B, S, GLA_HEADS, GLA_DV)
        o_a = gla_chunked(q_a, k_a, v_a, log_a.reshape(B, S, GLA_HEADS, GLA_DK))
        o_a = o_a * lax.rsqrt(jnp.mean(jnp.square(o_a), axis=-1, keepdims=True) + RMS_EPS) * gla_norm_w.astype(f32)
        o_a = (o_a.reshape(B, S, GLA_HEADS * GLA_DV) * jax.nn.silu(g_out.astype(f32))).astype(x.dtype)
        y_a = o_a @ w_branch_gla

        q_b = s_q.reshape(B, S, SWA_HEADS, SWA_HEAD_DIM)
        k_b = s_k.reshape(B, S, SWA_KV_HEADS, SWA_HEAD_DIM)
        v_b = s_v.reshape(B, S, SWA_KV_HEADS, SWA_HEAD_DIM)
        o_b = swa_banded(q_b, k_b, v_b, attn_sinks)
        y_b = o_b @ w_branch_swa

        merged = jax.nn.sigmoid(gate_gla) * y_a + jax.nn.sigmoid(gate_swa) * y_b
        mix = merged @ w_out
        x = layer_norm(DEEPNORM_ALPHA * x + mix, ln1_g, ln1_b)

        h = jnp.square(jax.nn.relu(x @ w_ff_up))
        x = layer_norm(DEEPNORM_ALPHA * x + h @ w_ff_down, ln2_g, ln2_b)
    return x
```

```cpp
#include <hip/hip_runtime.h>
#include <hip/hip_cooperative_groups.h>
#include <cstdio>
#include <cstdint>
namespace cg = cooperative_groups;

#define DI __device__ __forceinline__
#define LAS __attribute__((address_space(3)))
typedef unsigned short bf16_t;
typedef short bf16x8 __attribute__((ext_vector_type(8)));
typedef float f32x4 __attribute__((ext_vector_type(4)));
typedef float f32x2 __attribute__((ext_vector_type(2)));
typedef float f32x16 __attribute__((ext_vector_type(16)));
typedef unsigned u32x4 __attribute__((ext_vector_type(4)));
typedef unsigned u32x2 __attribute__((ext_vector_type(2)));
typedef __bf16 bf16v2 __attribute__((ext_vector_type(2)));

DI unsigned pk2(float lo, float hi) { f32x2 v = {lo, hi}; bf16v2 b = __builtin_convertvector(v, bf16v2); return __builtin_bit_cast(unsigned, b); }
DI bf16_t f2bf(float f) { return (bf16_t)(pk2(f, 0.f) & 0xffffu); }
DI float bflo(unsigned w) { return __uint_as_float(w << 16); }
DI float bfhi(unsigned w) { return __uint_as_float(w & 0xffff0000u); }
DI float bf2f(bf16_t b) { return __uint_as_float(((unsigned)b) << 16); }
DI int tid_opaque() { int t = threadIdx.x; asm volatile("" : "+v"(t)); return t; }
template <class Tp> DI Tp* redir(Tp* p, bool dry, unsigned char* ws) { return dry ? (Tp*)(ws + 984 * (size_t)1048576 + ((size_t)p & 0xFFFFF0)) : p; }
#define LBAR() do { asm volatile("s_waitcnt lgkmcnt(0)" ::: "memory"); __builtin_amdgcn_s_barrier(); asm volatile("" ::: "memory"); } while (0)
DI int crow(int i, int h) { return (i & 3) + 8 * (i >> 2) + 4 * h; }
#define MFMA32(a, b, c) __builtin_amdgcn_mfma_f32_32x32x16_bf16((a), (b), (c), 0, 0, 0)
#define MFMA16(a, b, c) __builtin_amdgcn_mfma_f32_16x16x32_bf16((a), (b), (c), 0, 0, 0)

constexpr int T = 32768, SEQ = 16384, D = 2048, NP = 12800, DFF = 8192;
constexpr int C_GQ = 0, C_GK = 1024, C_GV = 2048, C_GO = 4096, C_SQ = 6144, C_SK = 8192, C_SV = 8448, C_GG = 8704, C_GS = 10752, C_H = 4096;
constexpr float ALPHA = 1.189207115002721f;
constexpr size_t MiB = 1u << 20;
constexpr size_t WS_PROJ = 0, WS_WIN = 800 * MiB, WS_WAB = 850 * MiB, WS_WO = 866 * MiB, WS_WUP = 874 * MiB, WS_WDN = 906 * MiB,
                 WS_GLR = 938 * MiB, WS_W16 = 940 * MiB, WS_SC = 941 * MiB, WS_DEC = 957 * MiB, WS_SSQ = 959 * MiB, WS_LG = 964 * MiB, WS_DG = 981 * MiB, WS_CTL = 982 * MiB, WS_END = 1001 * MiB;
constexpr int LDS_BYTES = 131072 + 1024;
constexpr int NSCAN = 64, SWA_A = 128;
#ifndef PROBE
#define PROBE 0
#endif

namespace pg8 {
constexpr int BM = 256, BK = 64, HALF = 128, HTB = HALF * BK * 2, STAGE_BYTES = 8 * HTB, NXCD = 8, WGM = 8;
DI int lds_byte(int r, int c) { const int st = (r >> 4) * 2 + (c >> 5), rr = r & 15, cc = c & 31, ob = rr * 64 + cc * 2; return st * 1024 + (ob ^ (((ob >> 9) & 1) << 5)); }
DI void stage_rc(int b, int& R, int& C) { const int st = b / 1024, sb = b % 1024, swz = sb ^ (((sb >> 9) & 1) << 5); R = (st >> 1) * 16 + swz / 64; C = (st & 1) * 32 + (swz % 64) / 2; }
DI int perm32(int rho) { const int n = rho >> 4, i = rho & 15; return 8 * (i >> 2) + 4 * n + (i & 3); }
struct Unit { int pm, pn; };
struct Gemm { const bf16_t* A; const bf16_t* Bt; int M, N, K, lda, ldb; };
struct StaticOrder {
    int nM, nN, nwg, G, c;
    DI void init(int M, int N, int G_, int c_) { nM = M / BM; nN = N / BM; nwg = nM * nN; G = G_; c = c_; }
    DI bool next(int i, Unit& u) const {
        const long L = (long)i * G + c; if (L >= nwg) return false;
        int wgid = (int)L; { const int q = nwg / NXCD, r = nwg % NXCD, xcd = wgid % NXCD, off = wgid / NXCD; wgid = (xcd < r ? xcd * (q + 1) : r * (q + 1) + (xcd - r) * q) + off; }
        const int nig = WGM * nN, gid = wgid / nig, fm = gid * WGM, gsz = (nM - fm) < WGM ? (nM - fm) : WGM;
        u.pm = fm + ((wgid % nig) % gsz); u.pn = (wgid % nig) / gsz; return true;
    }
};
template <class Epi>
DI void gemm_phase(LAS unsigned char* lds, const Gemm g, const StaticOrder& S, const Epi& E) {
    const int tid = tid_opaque(), wid = __builtin_amdgcn_readfirstlane(tid >> 6), lane = tid & 63, wr = wid >> 2, wc = wid & 3, fr = lane & 15, fq = lane >> 4;
    const int K = g.K, nt = K / BK;
    unsigned voffA[2], voffB[2];
#pragma unroll
    for (int i = 0; i < 2; ++i) { int R, C; stage_rc(tid * 16 + i * 8192, R, C); const int Rb = Epi::PERM ? ((R & ~31) + perm32(R & 31)) : R;
        voffA[i] = (unsigned)(R * g.lda + C) * 2u; voffB[i] = (unsigned)(Rb * g.ldb + C) * 2u; }
    const size_t kstep = (size_t)(BK * 2);
    const size_t hA = (size_t)HALF * g.lda * 2, hB = (size_t)HALF * g.ldb * 2, tA = 2 * hA, tB = 2 * hB;
    const unsigned ldsw = (unsigned)wid * 1024u;
    const int aoff = lds_byte(wr * 64 + fr, fq * 8), boff = lds_byte(wc * 32 + fr, fq * 8);
#define PG8_SA(b, h) (((b) * 2 + (h)) * HTB)
#define PG8_SB(b, h) ((4 + (b) * 2 + (h)) * HTB)
#define PG8_STAGE(bufoff, gbase, voff) do { _Pragma("unroll") for (int _i = 0; _i < 2; ++_i) \
        __builtin_amdgcn_global_load_lds((const unsigned*)((const char*)(gbase) + (voff)[_i]), (LAS unsigned*)(lds + (bufoff) + ldsw + _i * 8192), 16, 0, 0); } while (0)
#define PG8_LDA(dst, b, h) do { _Pragma("unroll") for (int m = 0; m < 4; ++m) _Pragma("unroll") for (int k = 0; k < 2; ++k) dst[m][k] = *(const LAS bf16x8*)(lds + PG8_SA(b, h) + aoff + m * 2048 + k * 1024); } while (0)
#define PG8_LDB(dst, b, h) do { _Pragma("unroll") for (int n = 0; n < 2; ++n) _Pragma("unroll") for (int k = 0; k < 2; ++k) dst[n][k] = *(const LAS bf16x8*)(lds + PG8_SB(b, h) + boff + n * 2048 + k * 1024); } while (0)
#define PG8_MMA(ai, bj, At, Bt) do { __builtin_amdgcn_s_setprio(1); _Pragma("unroll") for (int m = 0; m < 4; ++m) _Pragma("unroll") for (int n = 0; n < 2; ++n) _Pragma("unroll") for (int k = 0; k < 2; ++k) \
        acc[ai][bj][m][n] = __builtin_amdgcn_mfma_f32_16x16x32_bf16(Bt[n][k], At[m][k], acc[ai][bj][m][n], 0, 0, 0); __builtin_amdgcn_s_setprio(0); } while (0)
#define PG8_WAIT_V(n) asm volatile("s_waitcnt vmcnt(" #n ")" ::: "memory")
#define PG8_WAIT_L(n) asm volatile("s_waitcnt lgkmcnt(" #n ")" ::: "memory")
#define PG8_BAR __builtin_amdgcn_s_barrier()
#define PG8_SCHED __builtin_amdgcn_sched_barrier(0)
    Unit cur, nxt; int ui = 0;
    if (!S.next(0, cur)) return;
    f32x4 acc[2][2][4][2];
#pragma unroll
    for (int a = 0; a < 2; ++a)
#pragma unroll
        for (int b = 0; b < 2; ++b)
#pragma unroll
            for (int m = 0; m < 4; ++m)
#pragma unroll
                for (int n = 0; n < 2; ++n) acc[a][b][m][n] = (f32x4){0.f, 0.f, 0.f, 0.f};
    bf16x8 At[4][2], B0[2][2], B1[2][2];
    const char* cA = (const char*)g.A + (size_t)cur.pm * tA; const char* cB = (const char*)g.Bt + (size_t)cur.pn * tB;
    PG8_STAGE(PG8_SB(0, 0), cB, voffB); PG8_STAGE(PG8_SB(0, 1), cB + hB, voffB); PG8_STAGE(PG8_SA(0, 0), cA, voffA); PG8_STAGE(PG8_SA(0, 1), cA + hA, voffA);
    if (wr == 1) PG8_BAR;
    PG8_WAIT_V(2); PG8_BAR;
    PG8_STAGE(PG8_SB(1, 0), cB + kstep, voffB); PG8_STAGE(PG8_SA(1, 0), cA + kstep, voffA); PG8_STAGE(PG8_SB(1, 1), cB + hB + kstep, voffB);
    PG8_WAIT_V(6); PG8_BAR;
    for (;;) {
        const bool has_next = S.next(ui + 1, nxt);
        const char* nA = has_next ? (const char*)g.A + (size_t)nxt.pm * tA : cA; const char* nB = has_next ? (const char*)g.Bt + (size_t)nxt.pn * tB : cB;
        constexpr int NSEG = Epi::MID ? 2 : 1;
#pragma unroll 1
        for (int sg = 0; sg < NSEG; ++sg) {
        const int tbeg = sg * (nt / NSEG), tend = (sg + 1) * (nt / NSEG);
#pragma unroll 1
        for (int t = tbeg; t < tend; t += 2) {
            const bool last = (t == nt - 2);
            const char* a1 = cA + (size_t)(t + 1) * kstep;
            const char* a2 = last ? nA : cA + (size_t)(t + 2) * kstep; const char* b2 = last ? nB : cB + (size_t)(t + 2) * kstep;
            const char* a3 = a2 + kstep; const char* b3 = b2 + kstep;
            const bool post_epi = (t == 0) && (ui > 0);
            PG8_LDB(B0, 0, 0); PG8_LDB(B1, 0, 1); PG8_SCHED; PG8_LDA(At, 0, 0); PG8_STAGE(PG8_SA(1, 1), a1 + hA, voffA);
            if (post_epi) PG8_WAIT_V(24); else PG8_WAIT_V(8);
            PG8_WAIT_L(0); PG8_BAR; PG8_MMA(0, 0, At, B0); PG8_MMA(0, 1, At, B1); PG8_BAR; PG8_SCHED;
            PG8_LDA(At, 0, 1); PG8_STAGE(PG8_SB(0, 0), b2, voffB); PG8_STAGE(PG8_SB(0, 1), b2 + hB, voffB); PG8_STAGE(PG8_SA(0, 0), a2, voffA);
            if (post_epi) PG8_WAIT_V(24); else PG8_WAIT_V(8);
            PG8_WAIT_L(0); PG8_BAR; PG8_MMA(1, 0, At, B0); PG8_MMA(1, 1, At, B1); PG8_BAR; PG8_SCHED;
            PG8_LDB(B0, 1, 0); PG8_LDB(B1, 1, 1); PG8_SCHED; PG8_LDA(At, 1, 0); PG8_STAGE(PG8_SA(0, 1), a2 + hA, voffA);
            PG8_WAIT_V(8); PG8_WAIT_L(0); PG8_BAR; PG8_MMA(0, 0, At, B0); PG8_MMA(0, 1, At, B1); PG8_BAR; PG8_SCHED;
            PG8_LDA(At, 1, 1); PG8_STAGE(PG8_SB(1, 0), b3, voffB); PG8_STAGE(PG8_SB(1, 1), b3 + hB, voffB); PG8_STAGE(PG8_SA(1, 0), a3, voffA);
            PG8_WAIT_V(8); PG8_WAIT_L(0); PG8_BAR; PG8_MMA(1, 0, At, B0); PG8_MMA(1, 1, At, B1); PG8_BAR; PG8_SCHED;
        }
        if constexpr (Epi::MID) { if (sg == 0) E.mid(acc, cur, wr, wc, fr, fq); }
        }
        if (wr == 0) PG8_BAR;
        E(acc, cur, wr, wc, fr, fq);
        if (!has_next) break;
#pragma unroll
        for (int a = 0; a < 2; ++a)
#pragma unroll
            for (int b = 0; b < 2; ++b)
#pragma unroll
                for (int m = 0; m < 4; ++m)
#pragma unroll
                    for (int n = 0; n < 2; ++n) acc[a][b][m][n] = (f32x4){0.f, 0.f, 0.f, 0.f};
        cur = nxt; cA = nA; cB = nB; ++ui;
        if (wr == 1) PG8_BAR;
    }
    PG8_WAIT_V(0);
    PG8_BAR;
#undef PG8_SA
#undef PG8_SB
#undef PG8_STAGE
#undef PG8_LDA
#undef PG8_LDB
#undef PG8_MMA
#undef PG8_WAIT_V
#undef PG8_WAIT_L
#undef PG8_BAR
#undef PG8_SCHED
}
}
typedef f32x4 AccT[2][2][4][2];

template <int ACT>
struct EpiBf16S {
    static constexpr bool PERM = true, MID = false; static constexpr int MID_T = -1;
    bf16_t* O; int ldc;
    DI void mid(AccT&, const pg8::Unit&, int, int, int, int) const {}
    DI void operator()(const AccT& acc, const pg8::Unit& u, int wr, int wc, int fr, int fq) const {
        const int row0 = u.pm * 256 + wr * 64 + fr, col0 = u.pn * 256 + wc * 32 + 8 * fq;
#pragma unroll
        for (int ai = 0; ai < 2; ++ai)
#pragma unroll
            for (int m = 0; m < 4; ++m) { bf16_t* rowp = O + (size_t)(row0 + ai * 128 + m * 16) * ldc + col0;
#pragma unroll
                for (int bj = 0; bj < 2; ++bj) { f32x4 v0 = acc[ai][bj][m][0], v1 = acc[ai][bj][m][1];
                    if (ACT == 1) {
#pragma unroll
                        for (int j = 0; j < 4; ++j) { const float a = fmaxf(v0[j], 0.f), b = fmaxf(v1[j], 0.f); v0[j] = a * a; v1[j] = b * b; } }
                    u32x4 w; w.x = pk2(v0[0], v0[1]); w.y = pk2(v0[2], v0[3]); w.z = pk2(v1[0], v1[1]); w.w = pk2(v1[2], v1[3]);
                    __builtin_nontemporal_store(w, (u32x4*)(rowp + bj * 128)); } }
    }
};
DI float sig_den(float g) { return 1.f + __expf(fminf(-g, 30.f)); }
struct EpiMerge {
    static constexpr bool PERM = true, MID = true; static constexpr int MID_T = 32;
    bf16_t* P;
    DI void mid(AccT& acc, const pg8::Unit& u, int wr, int wc, int fr, int fq) const {
        int row0 = u.pm * 256 + wr * 64 + fr; const int col0 = u.pn * 256 + wc * 32 + 8 * fq;
        asm volatile("" : "+v"(row0));
#pragma unroll
        for (int ai = 0; ai < 2; ++ai)
#pragma unroll
            for (int m = 0; m < 4; ++m) { const bf16_t* rowp = P + (unsigned)((row0 + ai * 128 + m * 16) * NP + col0);
#pragma unroll
                for (int bj = 0; bj < 2; ++bj) { const u32x4 gg = *(const u32x4*)(rowp + C_GG + bj * 128), gs = *(const u32x4*)(rowp + C_GS + bj * 128);
                    f32x4 ra, rb;
#pragma unroll
                    for (int q = 0; q < 2; ++q) { ra[2 * q] = sig_den(bflo(gs[q])) * __builtin_amdgcn_rcpf(sig_den(bflo(gg[q]))); ra[2 * q + 1] = sig_den(bfhi(gs[q])) * __builtin_amdgcn_rcpf(sig_den(bfhi(gg[q])));
                        rb[2 * q] = sig_den(bflo(gs[q + 2])) * __builtin_amdgcn_rcpf(sig_den(bflo(gg[q + 2]))); rb[2 * q + 1] = sig_den(bfhi(gs[q + 2])) * __builtin_amdgcn_rcpf(sig_den(bfhi(gg[q + 2]))); }
                    acc[ai][bj][m][0] *= ra; acc[ai][bj][m][1] *= rb;
                    asm volatile("" ::: "memory"); } }
    }
    DI void operator()(const AccT& acc, const pg8::Unit& u, int wr, int wc, int fr, int fq) const {
        int row0 = u.pm * 256 + wr * 64 + fr; const int col0 = u.pn * 256 + wc * 32 + 8 * fq;
        asm volatile("" : "+v"(row0));
#pragma unroll
        for (int ai = 0; ai < 2; ++ai)
#pragma unroll
            for (int m = 0; m < 4; ++m) { bf16_t* rowp = P + (unsigned)((row0 + ai * 128 + m * 16) * NP + col0);
#pragma unroll
                for (int bj = 0; bj < 2; ++bj) { const u32x4 gs = *(const u32x4*)(rowp + C_GS + bj * 128); u32x4 w;
#pragma unroll
                    for (int q = 0; q < 4; ++q) { const float s0 = __builtin_amdgcn_rcpf(sig_den(bflo(gs[q]))), s1 = __builtin_amdgcn_rcpf(sig_den(bfhi(gs[q])));
                        w[q] = pk2(acc[ai][bj][m][q >> 1][(q & 1) * 2] * s0, acc[ai][bj][m][q >> 1][(q & 1) * 2 + 1] * s1); }
                    *(u32x4*)(rowp + C_GG + bj * 128) = w; }
                asm volatile("" ::: "memory"); }
    }
};
struct EpiResF32 {
    static constexpr bool PERM = false, MID = false; static constexpr int MID_T = -1;
    const float* res; int ldr; float* out; int ldo;
    DI void mid(AccT&, const pg8::Unit&, int, int, int, int) const {}
    DI void operator()(const AccT& acc, const pg8::Unit& u, int wr, int wc, int fr, int fq) const {
        const int row0 = u.pm * 256 + wr * 64 + fr, col0 = u.pn * 256 + wc * 32 + 4 * fq;
#pragma unroll
        for (int ai = 0; ai < 2; ++ai)
#pragma unroll
            for (int m = 0; m < 4; ++m) { const size_t row = (size_t)(row0 + ai * 128 + m * 16); const float* rp = res + row * ldr + col0; float* op = out + row * ldo + col0;
#pragma unroll
                for (int bj = 0; bj < 2; ++bj)
#pragma unroll
                    for (int n = 0; n < 2; ++n) { const f32x4 rv = *(const f32x4*)(rp + bj * 128 + n * 16); *(f32x4*)(op + bj * 128 + n * 16) = rv * ALPHA + acc[ai][bj][m][n]; }
                asm volatile("" ::: "memory"); }
    }
};

struct EpiResBf {
    static constexpr bool PERM = false, MID = false; static constexpr int MID_T = -1;
    const bf16_t* res; int ldr; float* out; int ldo;
    DI void mid(AccT&, const pg8::Unit&, int, int, int, int) const {}
    DI void operator()(const AccT& acc, const pg8::Unit& u, int wr, int wc, int fr, int fq) const {
        const int row0 = u.pm * 256 + wr * 64 + fr, col0 = u.pn * 256 + wc * 32 + 4 * fq;
#pragma unroll
        for (int ai = 0; ai < 2; ++ai)
#pragma unroll
            for (int m = 0; m < 4; ++m) { const size_t row = (size_t)(row0 + ai * 128 + m * 16); const bf16_t* rp = res + row * ldr + col0; float* op = out + row * ldo + col0;
#pragma unroll
                for (int bj = 0; bj < 2; ++bj)
#pragma unroll
                    for (int n = 0; n < 2; ++n) { const u32x2 rw = *(const u32x2*)(rp + bj * 128 + n * 16); const f32x4 rv = {bflo(rw.x), bfhi(rw.x), bflo(rw.y), bfhi(rw.y)};
                        *(f32x4*)(op + bj * 128 + n * 16) = rv * ALPHA + acc[ai][bj][m][n]; }
                asm volatile("" ::: "memory"); }
    }
};

template <bool RESBF>
struct EpiResOutBf {
    static constexpr bool PERM = true, MID = false; static constexpr int MID_T = -1;
    const void* res; int ldr; bf16_t* out; int ldo;
    DI void mid(AccT&, const pg8::Unit&, int, int, int, int) const {}
    DI void operator()(const AccT& acc, const pg8::Unit& u, int wr, int wc, int fr, int fq) const {
        int row0 = u.pm * 256 + wr * 64 + fr; const int col0 = u.pn * 256 + wc * 32 + 8 * fq;
        asm volatile("" : "+v"(row0));
#pragma unroll
        for (int ai = 0; ai < 2; ++ai)
#pragma unroll
            for (int m = 0; m < 4; ++m) { const unsigned row = (unsigned)(row0 + ai * 128 + m * 16); bf16_t* op = out + (size_t)row * ldo + col0;
#pragma unroll
                for (int bj = 0; bj < 2; ++bj) { f32x4 r0, r1;
                    if (RESBF) { const u32x4 rw = *(const u32x4*)((const bf16_t*)res + (size_t)row * ldr + col0 + bj * 128); r0 = (f32x4){bflo(rw.x), bfhi(rw.x), bflo(rw.y), bfhi(rw.y)}; r1 = (f32x4){bflo(rw.z), bfhi(rw.z), bflo(rw.w), bfhi(rw.w)}; }
                    else { const float* rp = (const float*)res + (size_t)row * ldr + col0 + bj * 128; r0 = *(const f32x4*)rp; r1 = *(const f32x4*)(rp + 4); }
                    const f32x4 v0 = r0 * ALPHA + acc[ai][bj][m][0], v1 = r1 * ALPHA + acc[ai][bj][m][1];
                    u32x4 w; w.x = pk2(v0[0], v0[1]); w.y = pk2(v0[2], v0[3]); w.z = pk2(v1[0], v1[1]); w.w = pk2(v1[2], v1[3]);
                    *(u32x4*)(op + bj * 128) = w; }
                asm volatile("" ::: "memory"); }
    }
};

struct Args {
    const float *x, *w_in, *w_alpha_up, *b_alpha, *gla_norm_w, *attn_sinks, *w_branch_gla, *w_branch_swa, *w_out, *ln1_g, *ln1_b, *w_ff_up, *w_ff_down, *ln2_g, *ln2_b;
    float* out; unsigned char* ws;
};

struct WItem { const float* src; bf16_t* dst; int ldw, ldt; };
DI WItem witem(const Args& a, int it) {
    bf16_t* WinT = (bf16_t*)(a.ws + WS_WIN); bf16_t* WabT = (bf16_t*)(a.ws + WS_WAB); bf16_t* WoT = (bf16_t*)(a.ws + WS_WO); bf16_t* WupT = (bf16_t*)(a.ws + WS_WUP); bf16_t* WdnT = (bf16_t*)(a.ws + WS_WDN);
    constexpr int J0 = 32 * 192, J1 = 32 * 208, J3 = 32 * 64, J6 = 32 * 256;
    const float* W; int ldw, sc0, nblk, ldt, dr0 = 0, dk0 = 0; bf16_t* WT; int r = it;
    if (r < J0) { W = a.w_in; ldw = 12816; sc0 = 0; nblk = 192; WT = WinT; ldt = 2048; }
    else if ((r -= J0) < J1) { W = a.w_in; ldw = 12816; sc0 = 6160; nblk = 208; WT = WinT; ldt = 2048; dr0 = 6144; }
    else if ((r -= J1) < J3) { W = a.w_branch_gla; ldw = 2048; sc0 = 0; nblk = 64; WT = WabT; ldt = 4096; }
    else if ((r -= J3) < J3) { W = a.w_branch_swa; ldw = 2048; sc0 = 0; nblk = 64; WT = WabT; ldt = 4096; dk0 = 2048; }
    else if ((r -= J3) < J3) { W = a.w_out; ldw = 2048; sc0 = 0; nblk = 64; WT = WoT; ldt = 2048; }
    else if ((r -= J3) < J6) { W = a.w_ff_up; ldw = 8192; sc0 = 0; nblk = 256; WT = WupT; ldt = 2048; }
    else { r -= J6; W = a.w_ff_down; ldw = 2048; sc0 = 0; nblk = 64; WT = WdnT; ldt = 8192; }
    const int k0 = 64 * (r / nblk), n0 = 32 * (r % nblk);
    WItem w; w.src = W + (size_t)k0 * ldw + sc0 + n0; w.dst = WT + (size_t)(dr0 + n0) * ldt + dk0 + k0; w.ldw = ldw; w.ldt = ldt; return w;
}
DI void phase_weights(const Args& a, LAS unsigned char* lds, int G) {
    const int tid = tid_opaque(), lane = tid & 63, wave = tid >> 6;
    LAS float* scr = (LAS float*)(lds + wave * 8448);
    bf16_t* W16T = (bf16_t*)(a.ws + WS_W16);
    const int gw = blockIdx.x * 8 + wave, NGW = G * 8;
    constexpr int NIT = 32 * 192 + 32 * 208 + 3 * 32 * 64 + 32 * 256 + 128 * 64;
    float cur[32];
    int it = gw;
    if (it < NIT) { const WItem w = witem(a, it);
#pragma unroll
        for (int i = 0; i < 32; ++i) cur[i] = w.src[(size_t)(2 * i + (lane >> 5)) * w.ldw + (lane & 31)]; }
    for (; it < NIT; it += NGW) {
        const WItem w = witem(a, it);
#pragma unroll
        for (int i = 0; i < 32; ++i) scr[(2 * i + (lane >> 5)) * 33 + (lane & 31)] = cur[i];
        if (it + NGW < NIT) { const WItem wn = witem(a, it + NGW);
#pragma unroll
            for (int i = 0; i < 32; ++i) cur[i] = wn.src[(size_t)(2 * i + (lane >> 5)) * wn.ldw + (lane & 31)]; }
        asm volatile("s_waitcnt lgkmcnt(0)" ::: "memory");
        const int c = lane & 7;
#pragma unroll
        for (int j = 0; j < 4; ++j) { const int n = (lane >> 3) + 8 * j; const LAS float* sp = scr + (8 * c) * 33 + n;
            u32x4 o; o.x = pk2(sp[0 * 33], sp[1 * 33]); o.y = pk2(sp[2 * 33], sp[3 * 33]); o.z = pk2(sp[4 * 33], sp[5 * 33]); o.w = pk2(sp[6 * 33], sp[7 * 33]);
            *(u32x4*)(w.dst + (size_t)n * w.ldt + 8 * c) = o; }
        asm volatile("s_waitcnt lgkmcnt(0)" ::: "memory");
    }
    for (int idx = blockIdx.x * 512 + tid; idx < 32768; idx += G * 512) { const int k = idx >> 4, n = idx & 15; W16T[n * 2048 + k] = f2bf(a.w_in[(size_t)k * 12816 + 6144 + n]); }
}
DI void phase_x(const Args& a, int G) {
    const int tid = tid_opaque(), lane = tid & 63, wave = tid >> 6, fr = lane & 15, fq = lane >> 4;
    bf16_t* XB = (bf16_t*)a.out; const bf16_t* W16T = (const bf16_t*)(a.ws + WS_W16); float* GLR = (float*)(a.ws + WS_GLR);
    const int gw = blockIdx.x * 8 + wave, NGW = G * 8;
    for (int tile = gw; tile < T / 16; tile += NGW) {
        const int r0 = tile * 16;
        const float* xp = a.x + (size_t)(r0 + fr) * D + 8 * fq; bf16_t* xbp = XB + (size_t)(r0 + fr) * D + 8 * fq; const bf16_t* wp = W16T + fr * 2048 + 8 * fq;
        f32x4 acc = {0.f, 0.f, 0.f, 0.f};
        f32x4 xa[8], xb[8]; bf16x8 wa[4], wb[4];
#define X_LOAD(XV, WV, kb) do { _Pragma("unroll") for (int i = 0; i < 4; ++i) { const int ks = 4 * (kb) + i; XV[2 * i] = *(const f32x4*)(xp + 32 * ks); XV[2 * i + 1] = *(const f32x4*)(xp + 32 * ks + 4); WV[i] = *(const bf16x8*)(wp + 32 * ks); } } while (0)
#define X_PROC(XV, WV, kb) do { _Pragma("unroll") for (int i = 0; i < 4; ++i) { const int ks = 4 * (kb) + i; const f32x4 v0 = XV[2 * i], v1 = XV[2 * i + 1]; \
            u32x4 p; p.x = pk2(v0[0], v0[1]); p.y = pk2(v0[2], v0[3]); p.z = pk2(v1[0], v1[1]); p.w = pk2(v1[2], v1[3]); \
            *(u32x4*)(xbp + 32 * ks) = p; acc = MFMA16(__builtin_bit_cast(bf16x8, p), WV[i], acc); } } while (0)
        X_LOAD(xa, wa, 0);
#pragma unroll 1
        for (int kb = 0; kb < 16; kb += 2) {
            X_LOAD(xb, wb, kb + 1);
            X_PROC(xa, wa, kb);
            if (kb + 2 < 16) X_LOAD(xa, wa, kb + 2);
            X_PROC(xb, wb, kb + 1);
        }
#undef X_LOAD
#undef X_PROC
#pragma unroll
        for (int i = 0; i < 4; ++i) GLR[(size_t)(r0 + 4 * fq + i) * 16 + fr] = acc[i];
    }
}
DI float log_sigmoid_f(float z) { return fminf(z, 0.f) - __logf(1.f + __expf(-fabsf(z))); }
DI void phase_gla_prep(const Args& a, LAS unsigned char* lds, int G, bool dry) {
    const int tid = tid_opaque(), lane = tid & 63, wave = tid >> 6, d = tid & 255, sh = tid >> 8, r = lane & 31, hh = lane >> 5;
    bf16_t* P = (bf16_t*)(a.ws + WS_PROJ); const float* GLR = (const float*)(a.ws + WS_GLR); bf16_t* SC = (bf16_t*)(a.ws + WS_SC); float* DEC = (float*)(a.ws + WS_DEC);
    LAS float* glr_s = (LAS float*)lds; LAS float* tot = (LAS float*)(lds + 4096);
    LAS bf16_t* QI = (LAS bf16_t*)(lds + 8192); LAS bf16_t* KI = (LAS bf16_t*)(lds + 8192 + 33792); LAS bf16_t* KT = (LAS bf16_t*)(lds + 8192 + 2 * 33792);
    const int h = blockIdx.x & 3;
    float wu[16];
#pragma unroll
    for (int j = 0; j < 16; ++j) wu[j] = a.w_alpha_up[j * 1024 + h * 256 + d];
    const float ba = a.b_alpha[h * 256 + d];
    u32x4 rq[4], rk[4]; f32x4 rg;
#define PREP_LOAD(uu) do { const int t0_ = ((uu) >> 10) * SEQ + (((uu) & 1023) >> 2) * 64; \
        rg = ((const f32x4*)(GLR + (size_t)t0_ * 16))[tid & 255]; \
        _Pragma("unroll") for (int i = 0; i < 4; ++i) { const int c = tid + 512 * i, row = c >> 5, c16 = c & 31; const bf16_t* src = P + (size_t)(t0_ + row) * NP + h * 256 + c16 * 8; \
            rq[i] = *(const u32x4*)(src + C_GQ); rk[i] = *(const u32x4*)(src + C_GK); } } while (0)
    if ((int)blockIdx.x < 2048) PREP_LOAD((int)blockIdx.x);
    for (int u = blockIdx.x; u < 2048; u += G) {
        const int b = u >> 10, n = (u & 1023) >> 2, t0 = b * SEQ + n * 64;
        LBAR();
        if (tid < 256) ((LAS f32x4*)glr_s)[tid] = rg;
#pragma unroll
        for (int i = 0; i < 4; ++i) { const int c = tid + 512 * i, row = c >> 5, c16 = c & 31;
            *(LAS u32x4*)(QI + row * 264 + c16 * 8) = rq[i]; *(LAS u32x4*)(KI + row * 264 + c16 * 8) = rk[i]; }
        LBAR();
        float cs[32];
        { float cum = 0.f;
#pragma unroll
          for (int s = 0; s < 32; ++s) { const LAS float* gp = glr_s + (sh * 32 + s) * 16; float z = ba;
#pragma unroll
              for (int j = 0; j < 16; ++j) z += gp[j] * wu[j];
              cum += log_sigmoid_f(z) * 0.0625f; cs[s] = cum; }
          tot[sh * 256 + d] = cum; }
        LBAR();
        const float t0v = tot[d], t1v = tot[256 + d], blast = t0v + t1v, coff = sh ? t0v : 0.f;
        LAS unsigned* kt32 = (LAS unsigned*)KT;
#pragma unroll
        for (int s2 = 0; s2 < 16; ++s2) { float kd[2];
#pragma unroll
            for (int e = 0; e < 2; ++e) { const int s = sh * 32 + 2 * s2 + e; const float cum = cs[2 * s2 + e] + coff;
                const float q = bf2f(QI[s * 264 + d]), k = bf2f(KI[s * 264 + d]);
                QI[s * 264 + d] = f2bf(q * 0.0625f * __expf(cum)); KI[s * 264 + d] = f2bf(k * __expf(-cum)); kd[e] = k * __expf(blast - cum); }
            kt32[d * 36 + sh * 16 + s2] = pk2(kd[0], kd[1]); }
        if (u + G < 2048) PREP_LOAD(u + G);
        LBAR();
        if (wave < 4) { const int mt = wave >> 1, nt = wave & 1; f32x16 acc;
#pragma unroll
            for (int i = 0; i < 16; ++i) acc[i] = 0.f;
#pragma unroll 4
            for (int ks = 0; ks < 16; ++ks) { const bf16x8 av = *(const LAS bf16x8*)(QI + (32 * mt + r) * 264 + 16 * ks + 8 * hh), bv = *(const LAS bf16x8*)(KI + (32 * nt + r) * 264 + 16 * ks + 8 * hh);
                acc = MFMA32(av, bv, acc); }
            bf16_t* scp = redir(SC + (size_t)u * 4096, dry, a.ws);
#pragma unroll
            for (int i = 0; i < 16; ++i) { const int sq = 32 * mt + crow(i, hh), sk = 32 * nt + r; scp[sq * 64 + sk] = f2bf(sk <= sq ? acc[i] : 0.f); } }
#pragma unroll
        for (int i = 0; i < 4; ++i) { const int c = tid + 512 * i, row = c >> 5, c16 = c & 31;
            *(u32x4*)redir(P + (size_t)(t0 + row) * NP + C_GQ + h * 256 + c16 * 8, dry, a.ws) = *(const LAS u32x4*)(QI + row * 264 + c16 * 8); }
        { bf16_t* dst = redir(P + (size_t)(t0 + (d >> 2)) * NP + C_GK + h * 256 + (d & 3) * 64 + sh * 32, dry, a.ws);
#pragma unroll
          for (int i = 0; i < 4; ++i) *(u32x4*)(dst + 8 * i) = *(const LAS u32x4*)(KT + d * 72 + sh * 32 + 8 * i); }
        if (sh == 0) *redir(DEC + (size_t)u * 256 + d, dry, a.ws) = expf(blast);
    }
#undef PREP_LOAD
}
DI bf16x8 pack8(const f32x16& x, int s) {
    u32x4 p; p.x = pk2(x[8 * s], x[8 * s + 1]); p.y = pk2(x[8 * s + 2], x[8 * s + 3]); p.z = pk2(x[8 * s + 4], x[8 * s + 5]); p.w = pk2(x[8 * s + 6], x[8 * s + 7]);
    return __builtin_bit_cast(bf16x8, p);
}
DI bf16x8 ld2x8(const LAS bf16_t* p) { const u32x2 lo = *(const LAS u32x2*)p, hi = *(const LAS u32x2*)(p + 8); u32x4 v; v.x = lo.x; v.y = lo.y; v.z = hi.x; v.w = hi.y; return __builtin_bit_cast(bf16x8, v); }
DI unsigned bfsel(const u32x4& v, int j) { const unsigned w = v[j >> 1]; return (j & 1) ? (w >> 16) : (w & 0xffffu); }
template <bool FULL, bool NOLOAD = false>
DI void phase_gla_scan(const Args& a, LAS unsigned char* lds, int stream, int seg, bool dry) {
    const int tid = tid_opaque(), lane = tid & 63, wave = tid >> 6, r = lane & 31, hh = lane >> 5, wm = wave >> 1, wn = wave & 1;
    const int bh = stream >> 3, b = bh >> 2, h = bh & 3, sl = stream & 7, dv0 = sl * 64, nbeg = seg * 64;
    bf16_t* P = (bf16_t*)(a.ws + WS_PROJ); const bf16_t* SC = (const bf16_t*)(a.ws + WS_SC); const float* DEC = (const float*)(a.ws + WS_DEC); float* SSQ = (float*)(a.ws + WS_SSQ);
    float* LG = (float*)(a.ws + WS_LG); float* DG = (float*)(a.ws + WS_DG);
    LAS bf16_t* QIs = (LAS bf16_t*)lds; LAS bf16_t* KDs = (LAS bf16_t*)(lds + 33792); LAS bf16_t* VTs = (LAS bf16_t*)(lds + 70656);
    LAS bf16_t* SCs = (LAS bf16_t*)(lds + 79872); LAS float* DECs = (LAS float*)(lds + 89088); LAS float* PART = (LAS float*)lds;
    f32x16 S0, S1;
#pragma unroll
    for (int i = 0; i < 16; ++i) { S0[i] = 0.f; S1[i] = 0.f; }
    if (FULL) {
        for (int gg = 0; gg < seg; ++gg) { const float* lp = LG + ((size_t)(stream * 4 + gg) * 512 + tid) * 32; const float* dp = DG + (size_t)(stream * 4 + gg) * 256 + 64 * wm;
#pragma unroll
            for (int i4 = 0; i4 < 4; ++i4) { const f32x4 l0 = *(const f32x4*)(lp + 4 * i4), l1 = *(const f32x4*)(lp + 16 + 4 * i4);
#pragma unroll
                for (int e = 0; e < 4; ++e) { const int i = 4 * i4 + e; S0[i] = S0[i] * dp[crow(i, hh)] + l0[e]; S1[i] = S1[i] * dp[32 + crow(i, hh)] + l1[e]; } } }
    }
    float dprod = 1.f;
    u32x4 pq[4], pk[4], pva, pvb, psc, pdec;
    const int ldrow = tid >> 5, ldc16 = tid & 31, vp = tid & 31, vg8 = (tid >> 5) & 7, scrow = tid >> 3, scc8 = tid & 7;
#define SCAN_LOAD(nn) do { const int t0_ = b * SEQ + (nn) * 64, u_ = b * 1024 + (nn) * 4 + h; \
        _Pragma("unroll") for (int i = 0; i < 4; ++i) { const bf16_t* src = P + (size_t)(t0_ + ldrow + 16 * i) * NP + h * 256 + ldc16 * 8; if (FULL) pq[i] = *(const u32x4*)(src + C_GQ); pk[i] = *(const u32x4*)(src + C_GK); } \
        { const bf16_t* src = P + (size_t)(t0_ + 2 * vp) * NP + C_GV + h * 512 + dv0 + vg8 * 8; pva = *(const u32x4*)src; pvb = *(const u32x4*)(src + NP); } \
        if (FULL) psc = *(const u32x4*)(SC + (size_t)u_ * 4096 + scrow * 64 + scc8 * 8); \
        pdec = ((const u32x4*)(DEC + (size_t)u_ * 256))[tid & 63]; } while (0)
    SCAN_LOAD(nbeg);
#pragma unroll 1
    for (int n = nbeg; n < nbeg + 64; ++n) {
        const int t0 = b * SEQ + n * 64;
        LBAR();
#pragma unroll
        for (int i = 0; i < 4; ++i) { const int row = ldrow + 16 * i;
            if (FULL) *(LAS u32x4*)(QIs + row * 264 + ldc16 * 8) = pq[i];
            *(LAS u32x4*)(KDs + (4 * row + (ldc16 >> 3)) * 72 + (ldc16 & 7) * 8) = pk[i]; }
        if (tid < 256) { LAS unsigned* vt32 = (LAS unsigned*)VTs;
#pragma unroll
            for (int j = 0; j < 8; ++j) vt32[(vg8 * 8 + j) * 36 + vp] = bfsel(pva, j) | (bfsel(pvb, j) << 16); }
        if (FULL) *(LAS u32x4*)(SCs + scrow * 72 + scc8 * 8) = psc;
        if (tid < 64) ((LAS u32x4*)DECs)[tid] = pdec;
        if (!NOLOAD) { if (n + 1 < nbeg + 64) SCAN_LOAD(n + 1); }
        LBAR();
        f32x16 o0, o1;
        if (FULL) {
#pragma unroll
            for (int i = 0; i < 16; ++i) { o0[i] = 0.f; o1[i] = 0.f; }
#pragma unroll
            for (int tl = 0; tl < 2; ++tl)
#pragma unroll
                for (int s2 = 0; s2 < 2; ++s2) { const bf16x8 bfrag = pack8(tl ? S1 : S0, s2); const int dkb = 64 * wm + 32 * tl + 16 * s2 + 4 * hh;
                    o0 = MFMA32(ld2x8(QIs + r * 264 + dkb), bfrag, o0); o1 = MFMA32(ld2x8(QIs + (32 + r) * 264 + dkb), bfrag, o1); }
            { const bf16x8 bv = *(const LAS bf16x8*)(VTs + (32 * wn + r) * 72 + 16 * wm + 8 * hh);
              o0 = MFMA32(*(const LAS bf16x8*)(SCs + r * 72 + 16 * wm + 8 * hh), bv, o0); o1 = MFMA32(*(const LAS bf16x8*)(SCs + (32 + r) * 72 + 16 * wm + 8 * hh), bv, o1); }
        } else { if (tid < 256) dprod *= DECs[tid]; }
#pragma unroll
        for (int i = 0; i < 16; ++i) { S0[i] *= DECs[64 * wm + crow(i, hh)]; S1[i] *= DECs[64 * wm + 32 + crow(i, hh)]; }
#pragma unroll
        for (int ks = 0; ks < 4; ++ks) { const bf16x8 bv = *(const LAS bf16x8*)(VTs + (32 * wn + r) * 72 + 16 * ks + 8 * hh);
            S0 = MFMA32(*(const LAS bf16x8*)(KDs + (64 * wm + r) * 72 + 16 * ks + 8 * hh), bv, S0);
            S1 = MFMA32(*(const LAS bf16x8*)(KDs + (64 * wm + 32 + r) * 72 + 16 * ks + 8 * hh), bv, S1); }
        if (FULL) {
            LBAR();
#pragma unroll
            for (int i = 0; i < 16; ++i) { PART[(wm * 64 + crow(i, hh)) * 68 + 32 * wn + r] = o0[i]; PART[(wm * 64 + 32 + crow(i, hh)) * 68 + 32 * wn + r] = o1[i]; }
            LBAR();
            { const int s = tid >> 3, c8 = tid & 7; f32x4 a0 = {0.f, 0.f, 0.f, 0.f}, a1 = a0;
#pragma unroll
              for (int w4 = 0; w4 < 4; ++w4) { const LAS float* pp = PART + (w4 * 64 + s) * 68 + c8 * 8; a0 += *(const LAS f32x4*)pp; a1 += *(const LAS f32x4*)(pp + 4); }
              float ssq = a0[0] * a0[0] + a0[1] * a0[1] + a0[2] * a0[2] + a0[3] * a0[3] + a1[0] * a1[0] + a1[1] * a1[1] + a1[2] * a1[2] + a1[3] * a1[3];
              ssq += __shfl_xor(ssq, 1); ssq += __shfl_xor(ssq, 2); ssq += __shfl_xor(ssq, 4);
              if (c8 == 0) *redir(SSQ + (size_t)(t0 + s) * 32 + h * 8 + sl, dry, a.ws) = ssq;
              u32x4 w; w.x = pk2(a0[0], a0[1]); w.y = pk2(a0[2], a0[3]); w.z = pk2(a1[0], a1[1]); w.w = pk2(a1[2], a1[3]);
              *(u32x4*)redir(P + (size_t)(t0 + s) * NP + C_GV + h * 512 + dv0 + c8 * 8, dry, a.ws) = w; }
        }
    }
#undef SCAN_LOAD
    if (!FULL) {
        float* lp = LG + ((size_t)(stream * 4 + seg) * 512 + tid) * 32;
#pragma unroll
        for (int i4 = 0; i4 < 4; ++i4) { *(f32x4*)(lp + 4 * i4) = (f32x4){S0[4 * i4], S0[4 * i4 + 1], S0[4 * i4 + 2], S0[4 * i4 + 3]}; *(f32x4*)(lp + 16 + 4 * i4) = (f32x4){S1[4 * i4], S1[4 * i4 + 1], S1[4 * i4 + 2], S1[4 * i4 + 3]}; }
        if (tid < 256) DG[(size_t)(stream * 4 + seg) * 256 + tid] = dprod;
    }
}
DI void phase_gla_scan_p1(const Args& a, LAS unsigned char* lds, int stream, int seg) {
    const int tid = tid_opaque(), lane = tid & 63, wave = tid >> 6, r = lane & 31, hh = lane >> 5, wm = wave >> 1, wn = wave & 1;
    const int bh = stream >> 3, b = bh >> 2, h = bh & 3, sl = stream & 7, dv0 = sl * 64, nbeg = seg * 64;
    const bf16_t* P = (const bf16_t*)(a.ws + WS_PROJ); const float* DEC = (const float*)(a.ws + WS_DEC);
    float* LG = (float*)(a.ws + WS_LG); float* DG = (float*)(a.ws + WS_DG);
    LAS bf16_t* KDs = (LAS bf16_t*)(lds + 33792); LAS bf16_t* VTs = (LAS bf16_t*)(lds + 70656); LAS float* DECs = (LAS float*)(lds + 89088);
    f32x16 S0, S1;
#pragma unroll
    for (int i = 0; i < 16; ++i) { S0[i] = 0.f; S1[i] = 0.f; }
    float dprod = 1.f;
    const int ldrow = tid >> 5, ldc16 = tid & 31, vp = tid & 31, vg8 = (tid >> 5) & 7;
    const bf16_t* kbase = P + (size_t)(b * SEQ + ldrow) * NP + C_GK + h * 256 + ldc16 * 8;
    const bf16_t* vbase = P + (size_t)(b * SEQ + 2 * vp) * NP + C_GV + h * 512 + dv0 + vg8 * 8;
    const float* dbase = DEC + (size_t)(b * 1024 + h) * 256 + (tid & 63) * 4;
    u32x4 ak[4], ava, avb, adec, bk[4], bva, bvb, bdec;
#define P1_LOAD(K_, VA_, VB_, D_, nn) do { const size_t ro_ = (size_t)(nn) * 64 * NP; \
        _Pragma("unroll") for (int i = 0; i < 4; ++i) K_[i] = *(const u32x4*)(kbase + ro_ + (size_t)(16 * i) * NP); \
        VA_ = *(const u32x4*)(vbase + ro_); VB_ = *(const u32x4*)(vbase + ro_ + NP); D_ = *(const u32x4*)(dbase + (size_t)(nn) * 1024); } while (0)
#define P1_STEP(K_, VA_, VB_, D_, nnext) do { \
        LBAR(); \
        _Pragma("unroll") for (int i = 0; i < 4; ++i) { const int row = ldrow + 16 * i; *(LAS u32x4*)(KDs + (4 * row + (ldc16 >> 3)) * 72 + (ldc16 & 7) * 8) = K_[i]; } \
        if (tid < 256) { LAS unsigned* vt32 = (LAS unsigned*)VTs; _Pragma("unroll") for (int j = 0; j < 8; ++j) vt32[(vg8 * 8 + j) * 36 + vp] = bfsel(VA_, j) | (bfsel(VB_, j) << 16); } \
        if (tid < 64) ((LAS u32x4*)DECs)[tid] = D_; \
        if ((nnext) < nbeg + 64) P1_LOAD(K_, VA_, VB_, D_, (nnext)); \
        LBAR(); \
        if (tid < 256) dprod *= DECs[tid]; \
        _Pragma("unroll") for (int i = 0; i < 16; ++i) { S0[i] *= DECs[64 * wm + crow(i, hh)]; S1[i] *= DECs[64 * wm + 32 + crow(i, hh)]; } \
        _Pragma("unroll") for (int ks = 0; ks < 4; ++ks) { const bf16x8 bv = *(const LAS bf16x8*)(VTs + (32 * wn + r) * 72 + 16 * ks + 8 * hh); \
            S0 = MFMA32(*(const LAS bf16x8*)(KDs + (64 * wm + r) * 72 + 16 * ks + 8 * hh), bv, S0); \
            S1 = MFMA32(*(const LAS bf16x8*)(KDs + (64 * wm + 32 + r) * 72 + 16 * ks + 8 * hh), bv, S1); } } while (0)
    P1_LOAD(ak, ava, avb, adec, nbeg); P1_LOAD(bk, bva, bvb, bdec, nbeg + 1);
#pragma unroll 1
    for (int n = nbeg; n < nbeg + 64; n += 2) { P1_STEP(ak, ava, avb, adec, n + 2); P1_STEP(bk, bva, bvb, bdec, n + 3); }
#undef P1_LOAD
#undef P1_STEP
    float* lp = LG + ((size_t)(stream * 4 + seg) * 512 + tid) * 32;
#pragma unroll
    for (int i4 = 0; i4 < 4; ++i4) { *(f32x4*)(lp + 4 * i4) = (f32x4){S0[4 * i4], S0[4 * i4 + 1], S0[4 * i4 + 2], S0[4 * i4 + 3]}; *(f32x4*)(lp + 16 + 4 * i4) = (f32x4){S1[4 * i4], S1[4 * i4 + 1], S1[4 * i4 + 2], S1[4 * i4 + 3]}; }
    if (tid < 256) DG[(size_t)(stream * 4 + seg) * 256 + tid] = dprod;
}
DI void phase_swa(const Args& a, LAS unsigned char* lds, int ubeg, int ustep, int uend, bool dry) {
    const int tid = tid_opaque(), lane = tid & 63, wave = tid >> 6, r = lane & 31, hh = lane >> 5;
    bf16_t* P = (bf16_t*)(a.ws + WS_PROJ);
    LAS bf16_t* Ks = (LAS bf16_t*)lds; LAS bf16_t* VT = (LAS bf16_t*)(lds + 36864); LAS unsigned* VT32 = (LAS unsigned*)(lds + 36864);
    for (int u = ubeg; u < uend; u += ustep) {
        const int b = u >> 9, nb = (u & 511) >> 2, kh = u & 3, tq0 = b * SEQ + 128 * nb, tk0 = tq0 - 128;
        __syncthreads();
#pragma unroll
        for (int i = 0; i < 4; ++i) { const int c = tid + 512 * i, key = c >> 3, c8 = c & 7; u32x4 v = {0u, 0u, 0u, 0u};
            if (nb > 0 || key >= 128) v = *(const u32x4*)(P + (size_t)(tk0 + key) * NP + C_SK + kh * 64 + c8 * 8);
            *(LAS u32x4*)(Ks + key * 72 + c8 * 8) = v; }
#pragma unroll
        for (int i = 0; i < 2; ++i) { const int task = tid + 512 * i, p = task & 127, g8 = task >> 7; u32x4 va = {0u, 0u, 0u, 0u}, vb = va;
            if (nb > 0 || p >= 64) { const bf16_t* src = P + (size_t)(tk0 + 2 * p) * NP + C_SV + kh * 64 + g8 * 8; va = *(const u32x4*)src; vb = *(const u32x4*)(src + NP); }
#pragma unroll
            for (int j = 0; j < 8; ++j) VT32[(g8 * 8 + j) * 130 + p] = bfsel(va, j) | (bfsel(vb, j) << 16); }
        __syncthreads();
        const int hq = kh * 8 + wave; const float slope = exp2f(-0.25f * (float)(hq + 1)), sink = a.attn_sinks[hq];
        const float sl2 = slope * 1.4426950408889634f, c0l2 = 0.125f * 1.4426950408889634f, sink2 = sink * 1.4426950408889634f;
        bf16x8 bq[4];
        { const bf16_t* q0 = P + (size_t)(tq0 + r) * NP + C_SQ + hq * 64;
#pragma unroll
          for (int ks = 0; ks < 4; ++ks) bq[ks] = *(const bf16x8*)(q0 + 16 * ks + 8 * hh); }
#pragma unroll 1
        for (int j = 0; j < 4; ++j) {
            const size_t tq = (size_t)(tq0 + 32 * j + r);
            bf16_t* qrow = P + tq * NP + C_SQ + hq * 64;
            f32x16 st[5];
#pragma unroll
            for (int kt = 0; kt < 5; ++kt) { f32x16 acc;
#pragma unroll
                for (int i = 0; i < 16; ++i) acc[i] = 0.f;
#pragma unroll
                for (int ks = 0; ks < 4; ++ks) acc = MFMA32(*(const LAS bf16x8*)(Ks + (32 * (j + kt) + r) * 72 + 16 * ks + 8 * hh), bq[ks], acc);
                st[kt] = acc; }
            if (j < 3) { const bf16_t* qn = qrow + (size_t)32 * NP;
#pragma unroll
                for (int ks = 0; ks < 4; ++ks) bq[ks] = *(const bf16x8*)(qn + 16 * ks + 8 * hh); }
            float l;
            int b2 = r + 128 - 4 * hh; asm volatile("" : "+v"(b2));
            if (nb > 0) {
                const float sb = sl2 * (float)b2; float m = sink2;
#pragma unroll
                for (int kt = 0; kt < 5; ++kt)
#pragma unroll
                    for (int i = 0; i < 16; ++i) { const int cc = 32 * kt + (i & 3) + 8 * (i >> 2); float lg = fmaf(st[kt][i], c0l2, fmaf(sl2, (float)cc, -sb));
                        if (kt == 0) lg = (b2 - cc < 128) ? lg : -1e30f;
                        if (kt == 4) lg = (b2 - cc >= 0) ? lg : -1e30f;
                        st[kt][i] = lg; m = fmaxf(m, lg); }
                m = fmaxf(m, __shfl_xor(m, 32));
                l = 0.f;
#pragma unroll
                for (int kt = 0; kt < 5; ++kt)
#pragma unroll
                    for (int i = 0; i < 16; ++i) { const float p = __builtin_amdgcn_exp2f(st[kt][i] - m); st[kt][i] = p; l += p; }
                l += __shfl_xor(l, 32); l += __builtin_amdgcn_exp2f(sink2 - m);
            } else {
                float m = sink;
                const int minkf2 = (128 - 32 * j) - 4 * hh;
#pragma unroll
                for (int kt = 0; kt < 5; ++kt)
#pragma unroll
                    for (int i = 0; i < 16; ++i) { const int cc = 32 * kt + (i & 3) + 8 * (i >> 2), dist = b2 - cc; const bool valid = ((unsigned)dist < 128u) && (cc >= minkf2);
                        const float lg = valid ? st[kt][i] * 0.125f - slope * (float)dist : -1e30f; st[kt][i] = lg; m = fmaxf(m, lg); }
                m = fmaxf(m, __shfl_xor(m, 32));
                l = 0.f;
#pragma unroll
                for (int kt = 0; kt < 5; ++kt)
#pragma unroll
                    for (int i = 0; i < 16; ++i) { const float p = __expf(st[kt][i] - m); st[kt][i] = p; l += p; }
                l += __shfl_xor(l, 32); l += __expf(sink - m);
            }
            const float inv = 1.f / l;
            f32x16 oa, ob;
#pragma unroll
            for (int i = 0; i < 16; ++i) { oa[i] = 0.f; ob[i] = 0.f; }
#pragma unroll
            for (int kt = 0; kt < 5; ++kt)
#pragma unroll
                for (int s2 = 0; s2 < 2; ++s2) { const bf16x8 bfrag = pack8(st[kt], s2); const int keyb = 32 * (j + kt) + 16 * s2 + 4 * hh;
                    oa = MFMA32(ld2x8(VT + r * 260 + keyb), bfrag, oa); ob = MFMA32(ld2x8(VT + (32 + r) * 260 + keyb), bfrag, ob); }
#pragma unroll
            for (int i4 = 0; i4 < 4; ++i4) { const int d0 = 8 * i4 + 4 * hh; u32x2 w0, w1;
                w0.x = pk2(oa[4 * i4] * inv, oa[4 * i4 + 1] * inv); w0.y = pk2(oa[4 * i4 + 2] * inv, oa[4 * i4 + 3] * inv);
                w1.x = pk2(ob[4 * i4] * inv, ob[4 * i4 + 1] * inv); w1.y = pk2(ob[4 * i4 + 2] * inv, ob[4 * i4 + 3] * inv);
                *(u32x2*)redir(qrow + d0, dry, a.ws) = w0; *(u32x2*)redir(qrow + 32 + d0, dry, a.ws) = w1; }
        }
    }
}
DI void phase_gla_norm(const Args& a, int G, bool dry) {
    const int tid = tid_opaque(), lane = tid & 63, wave = tid >> 6;
    bf16_t* P = (bf16_t*)(a.ws + WS_PROJ); const float* SSQ = (const float*)(a.ws + WS_SSQ);
    const f32x4 w0 = *(const f32x4*)(a.gla_norm_w + lane * 8), w1 = *(const f32x4*)(a.gla_norm_w + lane * 8 + 4);
    const float wv[8] = {w0[0], w0[1], w0[2], w0[3], w1[0], w1[1], w1[2], w1[3]};
    u32x4 o8[4], g8[4]; f32x4 sq[8];
#define NORM_LOAD(tt) do { const bf16_t* rp_ = P + (size_t)(tt) * NP + lane * 8; \
        _Pragma("unroll") for (int j = 0; j < 4; ++j) { o8[j] = *(const u32x4*)(rp_ + C_GV + j * 512); g8[j] = *(const u32x4*)(rp_ + C_GO + j * 512); \
            sq[2 * j] = *(const f32x4*)(SSQ + (size_t)(tt) * 32 + j * 8); sq[2 * j + 1] = *(const f32x4*)(SSQ + (size_t)(tt) * 32 + j * 8 + 4); } } while (0)
    int t = blockIdx.x * 8 + wave;
    if (t < T) NORM_LOAD(t);
    for (; t < T; t += G * 8) {
        bf16_t* rowp = P + (size_t)t * NP;
        u32x4 wout[4];
#pragma unroll
        for (int j = 0; j < 4; ++j) { const f32x4 s0 = sq[2 * j], s1 = sq[2 * j + 1];
            const float ss = (s0[0] + s0[1]) + (s0[2] + s0[3]) + (s1[0] + s1[1]) + (s1[2] + s1[3]); const float rstd = rsqrtf(ss * (1.f / 512.f) + 1e-6f);
#pragma unroll
            for (int q = 0; q < 4; ++q) { const float ga = bflo(g8[j][q]), gb = bfhi(g8[j][q]);
                const float ra = bflo(o8[j][q]) * rstd * wv[2 * q] * (ga / (1.f + __expf(-ga))), rb = bfhi(o8[j][q]) * rstd * wv[2 * q + 1] * (gb / (1.f + __expf(-gb)));
                wout[j][q] = pk2(ra, rb); } }
        if (t + G * 8 < T) NORM_LOAD(t + G * 8);
#pragma unroll
        for (int j = 0; j < 4; ++j) *(u32x4*)redir(rowp + C_GO + j * 512 + lane * 8, dry, a.ws) = wout[j];
    }
#undef NORM_LOAD
}
template <bool BF, bool F32OUT>
DI void phase_ln(const float* in, int ldi, float* out, int ldo, bf16_t* ob, int ldb, const float* gam, const float* bet, int G, bool dry, unsigned char* ws) {
    const int tid = tid_opaque(), lane = tid & 63, wave = tid >> 6;
    for (int t = blockIdx.x * 8 + wave; t < T; t += G * 8) {
        const float* ip = in + (size_t)t * ldi + lane * 4; f32x4 v[8]; float s = 0.f;
#pragma unroll
        for (int j = 0; j < 8; ++j) { v[j] = *(const f32x4*)(ip + j * 256); s += (v[j][0] + v[j][1]) + (v[j][2] + v[j][3]); }
#pragma unroll
        for (int o = 1; o < 64; o <<= 1) s += __shfl_xor(s, o);
        const float mean = s * (1.f / 2048.f); float q = 0.f;
#pragma unroll
        for (int j = 0; j < 8; ++j) { v[j] = v[j] - mean; q += (v[j][0] * v[j][0] + v[j][1] * v[j][1]) + (v[j][2] * v[j][2] + v[j][3] * v[j][3]); }
#pragma unroll
        for (int o = 1; o < 64; o <<= 1) q += __shfl_xor(q, o);
        const float rstd = rsqrtf(q * (1.f / 2048.f) + 1e-5f);
        float* op = out + (size_t)t * ldo + lane * 4;
#pragma unroll
        for (int j = 0; j < 8; ++j) { const f32x4 gv = *(const f32x4*)(gam + j * 256 + lane * 4), bv = *(const f32x4*)(bet + j * 256 + lane * 4); const f32x4 y = v[j] * rstd * gv + bv;
            if (F32OUT) *(f32x4*)redir(op + j * 256, dry, ws) = y;
            if (BF) { u32x2 w; w.x = pk2(y[0], y[1]); w.y = pk2(y[2], y[3]); *(u32x2*)redir(ob + (size_t)t * ldb + j * 256 + lane * 4, dry, ws) = w; } }
    }
}


template <bool F32OUT>
DI void phase_ln_bf(const bf16_t* in, int ldi, float* outf, int ldo, bf16_t* ob, int ldb, const float* gam, const float* bet, int G, bool dry, unsigned char* ws) {
    const int tid = tid_opaque(), lane = tid & 63, wave = tid >> 6;
    u32x4 nx[4];
    int t = blockIdx.x * 8 + wave;
    if (t < T) {
#pragma unroll
        for (int j = 0; j < 4; ++j) nx[j] = *(const u32x4*)(in + (size_t)t * ldi + lane * 8 + j * 512); }
    for (; t < T; t += G * 8) {
        f32x4 v[8]; float s = 0.f;
#pragma unroll
        for (int j = 0; j < 4; ++j) { const u32x4 w = nx[j]; v[2 * j] = (f32x4){bflo(w.x), bfhi(w.x), bflo(w.y), bfhi(w.y)}; v[2 * j + 1] = (f32x4){bflo(w.z), bfhi(w.z), bflo(w.w), bfhi(w.w)};
            s += ((v[2 * j][0] + v[2 * j][1]) + (v[2 * j][2] + v[2 * j][3])) + ((v[2 * j + 1][0] + v[2 * j + 1][1]) + (v[2 * j + 1][2] + v[2 * j + 1][3])); }
        if (t + G * 8 < T) {
#pragma unroll
            for (int j = 0; j < 4; ++j) nx[j] = *(const u32x4*)(in + (size_t)(t + G * 8) * ldi + lane * 8 + j * 512); }
#pragma unroll
        for (int o = 1; o < 64; o <<= 1) s += __shfl_xor(s, o);
        const float mean = s * (1.f / 2048.f); float q = 0.f;
#pragma unroll
        for (int j = 0; j < 8; ++j) { v[j] = v[j] - mean; q += (v[j][0] * v[j][0] + v[j][1] * v[j][1]) + (v[j][2] * v[j][2] + v[j][3] * v[j][3]); }
#pragma unroll
        for (int o = 1; o < 64; o <<= 1) q += __shfl_xor(q, o);
        const float rstd = rsqrtf(q * (1.f / 2048.f) + 1e-5f);
#pragma unroll
        for (int j = 0; j < 4; ++j) { const int col = j * 512 + lane * 8;
            const f32x4 g0 = *(const f32x4*)(gam + col), g1 = *(const f32x4*)(gam + col + 4), b0 = *(const f32x4*)(bet + col), b1 = *(const f32x4*)(bet + col + 4);
            const f32x4 y0 = v[2 * j] * rstd * g0 + b0, y1 = v[2 * j + 1] * rstd * g1 + b1;
            if (F32OUT) { float* op = outf + (size_t)t * ldo + col; *(f32x4*)redir(op, dry, ws) = y0; *(f32x4*)redir(op + 4, dry, ws) = y1; }
            else { u32x4 w; w.x = pk2(y0[0], y0[1]); w.y = pk2(y0[2], y0[3]); w.z = pk2(y1[0], y1[1]); w.w = pk2(y1[2], y1[3]); *(u32x4*)redir(ob + (size_t)t * ldb + col, dry, ws) = w; } }
    }
}

#define XB_TMO      128
#define XB_XCNT(j)  (256  + 64 * (j))
#define XB_XSUB(j)  (1280 + 64 * (j))
#define XB_XGEN(j)  (2304 + 64 * (j))
#define XB_TOP      3328
#define XB_TOPGEN   3392
#define XCD_BAR_WORDS 3456
#define XB_SPIN_CAP (1u << 18)
DI unsigned xb_ld(unsigned* p)              { return __hip_atomic_load(p, __ATOMIC_RELAXED, __HIP_MEMORY_SCOPE_AGENT); }
DI unsigned xb_add(unsigned* p, unsigned v) { return __hip_atomic_fetch_add(p, v, __ATOMIC_RELAXED, __HIP_MEMORY_SCOPE_AGENT); }
DI unsigned xb_xcc_id() { return (unsigned)__builtin_amdgcn_s_getreg((3 << 11) | 20) & 0xFu; }
#define XB_SPIN(cond, bar) do { unsigned _sp = 0; while (cond) { __builtin_amdgcn_s_sleep(1); \
    if ((++_sp & 255u) == 0u) { if (xb_ld(&(bar)[XB_TMO])) break; if (_sp > XB_SPIN_CAP) { atomicAdd(&(bar)[XB_TMO], 1u); break; } } } } while (0)
struct XcdBarrier { unsigned* bar; unsigned x; volatile LAS unsigned* st; };
DI XcdBarrier xcd_barrier_post(unsigned* bar, volatile LAS unsigned* st) {
    XcdBarrier b; b.bar = bar; b.x = xb_xcc_id(); b.st = st;
    if (threadIdx.x == 0) (void)xb_add(&bar[XB_XCNT(b.x)], 1u);
    return b;
}
DI void xcd_barrier_complete(unsigned* bar, unsigned x, unsigned& nloc, unsigned& nx) {
    const unsigned G = gridDim.x * gridDim.y * gridDim.z;
    unsigned sum, cnt, mine, sp = 0u;
    for (;;) {
        sum = 0u; cnt = 0u; mine = 0u;
#pragma unroll
        for (unsigned j = 0; j < 16; ++j) { const unsigned c = xb_ld(&bar[XB_XCNT(j)]); sum += c; cnt += (c > 0u) ? 1u : 0u; mine = (j == x) ? c : mine; }
        if (sum == G) break;
        __builtin_amdgcn_s_sleep(1);
        if ((++sp & 255u) == 0u) { if (xb_ld(&bar[XB_TMO])) break; if (sp > XB_SPIN_CAP) { atomicAdd(&bar[XB_TMO], 1u); break; } }
    }
    nloc = mine > 0u ? mine : 1u; nx = cnt > 0u ? cnt : 1u;
}
DI void xcd_barrier(const XcdBarrier& b) {
    asm volatile("s_waitcnt vmcnt(0)" ::: "memory");
    __syncthreads();
    if (threadIdx.x == 0) {
        unsigned* bar = b.bar;
        __builtin_amdgcn_s_waitcnt(0);
        unsigned nloc = b.st[0], nx = b.st[1];
        if (nloc == 0u) { xcd_barrier_complete(bar, b.x, nloc, nx); b.st[0] = nloc; b.st[1] = nx; }
        const unsigned old = xb_add(&bar[XB_XSUB(b.x)], 1u);
        const unsigned gen = old / nloc;
        if (old + 1u == (gen + 1u) * nloc) {
            __builtin_amdgcn_fence(__ATOMIC_RELEASE, "agent");
            asm volatile("s_waitcnt vmcnt(0)" ::: "memory");
            const unsigned og = xb_add(&bar[XB_TOP], 1u);
            const unsigned tg = og / nx;
            if (og + 1u == (tg + 1u) * nx) xb_add(&bar[XB_TOPGEN], 1u);
            else XB_SPIN(xb_ld(&bar[XB_TOPGEN]) == tg, bar);
            __builtin_amdgcn_fence(__ATOMIC_ACQUIRE, "agent");
            xb_add(&bar[XB_XGEN(b.x)], 1u);
            asm volatile("s_waitcnt vmcnt(0)" ::: "memory");
        } else {
            XB_SPIN(xb_ld(&bar[XB_XGEN(b.x)]) == gen, bar);
            __builtin_amdgcn_fence(__ATOMIC_ACQUIRE, "agent");
            asm volatile("s_waitcnt vmcnt(0)" ::: "memory");
        }
    }
    __syncthreads();
}

__global__ void __launch_bounds__(512, 2) mega(Args a) {
    extern __shared__ __attribute__((aligned(16))) unsigned char lds_raw[];
    LAS unsigned char* lds = (LAS unsigned char*)lds_raw;
    cg::grid_group grid = cg::this_grid();
    const int G = gridDim.x;
    { volatile LAS unsigned* st0 = (volatile LAS unsigned*)(lds + 131072 + 32); if (threadIdx.x == 0) { st0[0] = 0u; st0[1] = 0u; } __syncthreads(); }
    XcdBarrier xbar = xcd_barrier_post((unsigned*)(a.ws + WS_CTL), (volatile LAS unsigned*)(lds + 131072 + 32));
#define GSYNC() xcd_barrier(xbar)
    bf16_t* P = (bf16_t*)(a.ws + WS_PROJ);
    bf16_t* XB = (bf16_t*)a.out;
    float* V1 = (float*)(a.ws + WS_PROJ);

    if (a.ws == nullptr) grid.sync();
    phase_weights(a, lds, G);
    GSYNC();
    if (PROBE & 1024) { for (int i = 0; i < 20; ++i) GSYNC(); }
    phase_x(a, G);
    GSYNC();
    if (PROBE & 64) { phase_weights(a, lds, G); GSYNC(); phase_x(a, G); GSYNC(); }
    {
        pg8::Gemm g{XB, (const bf16_t*)(a.ws + WS_WIN), T, NP, D, D, D}; pg8::StaticOrder S; S.init(T, NP, G, (int)blockIdx.x);
        EpiBf16S<0> E{P, NP}; pg8::gemm_phase(lds, g, S, E);
        if (PROBE & 1) { GSYNC(); pg8::gemm_phase(lds, g, S, E); }
    }
    GSYNC();
    if (PROBE & 4) { phase_gla_prep(a, lds, G, true); GSYNC(); }
    phase_gla_prep(a, lds, G, false);
    GSYNC();
    {
        const int blk = (int)blockIdx.x, xcd = blk & 7, jx = blk >> 3, q = xcd * 4 + (jx >> 3), seg = q >> 3, stream = (q & 7) * 8 + (jx & 7);
        if (PROBE & 8) { if (seg < 3) phase_gla_scan<false>(a, lds, stream, seg, false); else phase_swa(a, lds, (xcd - 6) * 32 + jx, 64, SWA_A, true);
            GSYNC(); phase_gla_scan<true>(a, lds, stream, seg, true); phase_swa(a, lds, SWA_A + blk, G, 1024, true); GSYNC(); }
        if (PROBE & 16) { if (seg < 3) phase_gla_scan<false>(a, lds, stream, seg, false); GSYNC(); }
        if (PROBE & 256) { phase_gla_scan<true>(a, lds, stream, seg, true); GSYNC(); }
        if (PROBE & 512) { phase_swa(a, lds, blk, G, 1024, true); GSYNC(); }
        if (seg < 3) phase_gla_scan_p1(a, lds, stream, seg); else phase_swa(a, lds, (xcd - 6) * 32 + jx, 64, SWA_A, false);
        GSYNC();
        phase_gla_scan<true>(a, lds, stream, seg, false);
        phase_swa(a, lds, SWA_A + blk, G, 1024, false);
    }
    GSYNC();
    if (PROBE & 32) { phase_gla_norm(a, G, true); GSYNC(); }
    phase_gla_norm(a, G, false);
    GSYNC();
    {
        pg8::Gemm g{P + C_GO, (const bf16_t*)(a.ws + WS_WAB), T, D, 2 * D, NP, 2 * D}; pg8::StaticOrder S; S.init(T, D, G, (int)blockIdx.x);
        EpiMerge E{P}; pg8::gemm_phase(lds, g, S, E);
    }
    GSYNC();
    {
        pg8::Gemm g{P + C_GG, (const bf16_t*)(a.ws + WS_WO), T, D, D, NP, D}; pg8::StaticOrder S; S.init(T, D, G, (int)blockIdx.x);
        EpiResOutBf<false> E{a.x, D, P, NP}; pg8::gemm_phase(lds, g, S, E);
        if (PROBE & 2) { GSYNC(); pg8::gemm_phase(lds, g, S, E); }
    }
    GSYNC();
    if (PROBE & 128) { phase_ln_bf<false>(P, NP, nullptr, 0, P, NP, a.ln1_g, a.ln1_b, G, true, a.ws); GSYNC(); }
    phase_ln_bf<false>(P, NP, nullptr, 0, P, NP, a.ln1_g, a.ln1_b, G, false, a.ws);
    GSYNC();
    {
        pg8::Gemm g{P, (const bf16_t*)(a.ws + WS_WUP), T, DFF, D, NP, D}; pg8::StaticOrder S; S.init(T, DFF, G, (int)blockIdx.x);
        EpiBf16S<1> E{P + C_H, NP}; pg8::gemm_phase(lds, g, S, E);
        if (PROBE & 2) { GSYNC(); pg8::gemm_phase(lds, g, S, E); }
    }
    GSYNC();
    {
        pg8::Gemm g{P + C_H, (const bf16_t*)(a.ws + WS_WDN), T, D, DFF, NP, DFF}; pg8::StaticOrder S; S.init(T, D, G, (int)blockIdx.x);
        EpiResOutBf<true> E{P, NP, P + C_GV, NP}; pg8::gemm_phase(lds, g, S, E);
        if (PROBE & 2) { GSYNC(); pg8::gemm_phase(lds, g, S, E); }
    }
    GSYNC();
    if (PROBE & 128) { phase_ln_bf<true>(P + C_GV, NP, a.out, D, nullptr, 0, a.ln2_g, a.ln2_b, G, true, a.ws); GSYNC(); }
    phase_ln_bf<true>(P + C_GV, NP, a.out, D, nullptr, 0, a.ln2_g, a.ln2_b, G, false, a.ws);
}

extern "C" void kernel_launch(void* const* d_in, const int* in_sizes, int n_in, void* d_out, int out_size, void* d_ws, size_t ws_size, hipStream_t stream) {
    static int grid = 0;
    if (grid == 0) {
        if (n_in != 15 || in_sizes[0] != T * D || out_size != T * D || ws_size < WS_END) { fprintf(stderr, "kernel_launch: unexpected shapes / workspace (%zu)\n", ws_size); grid = -1; return; }
        int dev = 0, cus = 0, per_cu = 0;
        hipGetDevice(&dev); hipDeviceGetAttribute(&cus, hipDeviceAttributeMultiprocessorCount, dev);
        hipFuncSetAttribute((const void*)mega, hipFuncAttributeMaxDynamicSharedMemorySize, LDS_BYTES);
        hipOccupancyMaxActiveBlocksPerMultiprocessor(&per_cu, (const void*)mega, 512, LDS_BYTES);
        if (per_cu < 1) { fprintf(stderr, "kernel_launch: occupancy 0\n"); per_cu = 1; }
        grid = cus;
        if (grid != 256) { fprintf(stderr, "kernel_launch: built for 256 CUs\n"); grid = -1; return; }
    }
    if (grid < 0) return;
    if (hipMemsetAsync((char*)d_ws + WS_CTL, 0, 65536, stream) != hipSuccess) { fprintf(stderr, "kernel_launch: memset failed\n"); return; }
    Args a{};
    a.x = (const float*)d_in[0]; a.w_in = (const float*)d_in[1]; a.w_alpha_up = (const float*)d_in[2]; a.b_alpha = (const float*)d_in[3];
    a.gla_norm_w = (const float*)d_in[4]; a.attn_sinks = (const float*)d_in[5]; a.w_branch_gla = (const float*)d_in[6]; a.w_branch_swa = (const float*)d_in[7];
    a.w_out = (const float*)d_in[8]; a.ln1_g = (const float*)d_in[9]; a.ln1_b = (const float*)d_in[10]; a.w_ff_up = (const float*)d_in[11];
    a.w_ff_down = (const float*)d_in[12]; a.ln2_g = (const float*)d_in[13]; a.ln2_b = (const float*)d_in[14];
    a.out = (float*)d_out; a.ws = (unsigned char*)d_ws;
    void* args[] = {&a};
    hipError_t e = hipLaunchCooperativeKernel((const void*)mega, dim3(grid), dim3(512), args, LDS_BYTES, stream);
    if (e != hipSuccess) fprintf(stderr, "cooperative launch failed: %s (grid %d)\n", hipGetErrorString(e), grid);
}
```

```cpp
#include <hip/hip_runtime.h>
#include <hip/hip_cooperative_groups.h>
#include <cstdio>
#include <cstdint>
namespace cg = cooperative_groups;

#define DI __device__ __forceinline__
#define LAS __attribute__((address_space(3)))
typedef unsigned short bf16_t;
typedef short bf16x8 __attribute__((ext_vector_type(8)));
typedef float f32x4 __attribute__((ext_vector_type(4)));
typedef float f32x2 __attribute__((ext_vector_type(2)));
typedef float f32x16 __attribute__((ext_vector_type(16)));
typedef unsigned u32x4 __attribute__((ext_vector_type(4)));
typedef unsigned u32x2 __attribute__((ext_vector_type(2)));
typedef __bf16 bf16v2 __attribute__((ext_vector_type(2)));

DI unsigned pk2(float lo, float hi) { f32x2 v = {lo, hi}; bf16v2 b = __builtin_convertvector(v, bf16v2); return __builtin_bit_cast(unsigned, b); }
DI bf16_t f2bf(float f) { return (bf16_t)(pk2(f, 0.f) & 0xffffu); }
DI float bflo(unsigned w) { return __uint_as_float(w << 16); }
DI float bfhi(unsigned w) { return __uint_as_float(w & 0xffff0000u); }
DI float bf2f(bf16_t b) { return __uint_as_float(((unsigned)b) << 16); }
DI int tid_opaque() { int t = threadIdx.x; asm volatile("" : "+v"(t)); return t; }
template <class Tp> DI Tp* redir(Tp* p, bool dry, unsigned char* ws) { return dry ? (Tp*)(ws + 984 * (size_t)1048576 + ((size_t)p & 0xFFFFF0)) : p; }
#define LBAR() do { asm volatile("s_waitcnt lgkmcnt(0)" ::: "memory"); __builtin_amdgcn_s_barrier(); asm volatile("" ::: "memory"); } while (0)
DI int crow(int i, int h) { return (i & 3) + 8 * (i >> 2) + 4 * h; }
#define MFMA32(a, b, c) __builtin_amdgcn_mfma_f32_32x32x16_bf16((a), (b), (c), 0, 0, 0)
#define MFMA16(a, b, c) __builtin_amdgcn_mfma_f32_16x16x32_bf16((a), (b), (c), 0, 0, 0)

constexpr int T = 32768, SEQ = 16384, D = 2048, NP = 12800, DFF = 8192;
constexpr int C_GQ = 0, C_GK = 1024, C_GV = 2048, C_GO = 4096, C_SQ = 6144, C_SK = 8192, C_SV = 8448, C_GG = 8704, C_GS = 10752, C_H = 4096;
constexpr float ALPHA = 1.189207115002721f;
constexpr size_t MiB = 1u << 20;
constexpr size_t WS_PROJ = 0, WS_WIN = 800 * MiB, WS_WAB = 850 * MiB, WS_WO = 866 * MiB, WS_WUP = 874 * MiB, WS_WDN = 906 * MiB,
                 WS_GLR = 938 * MiB, WS_W16 = 940 * MiB, WS_SC = 941 * MiB, WS_DEC = 957 * MiB, WS_SSQ = 959 * MiB, WS_LG = 964 * MiB, WS_DG = 981 * MiB, WS_CTL = 982 * MiB, WS_END = 1001 * MiB;
constexpr int LDS_BYTES = 131072 + 1024;
constexpr int NSCAN = 64, SWA_A = 256;
#ifndef PROBE
#define PROBE 0
#endif

namespace pg8 {
constexpr int BM = 256, BK = 64, HALF = 128, HTB = HALF * BK * 2, STAGE_BYTES = 8 * HTB, NXCD = 8, WGM = 8;
DI int lds_byte(int r, int c) { const int st = (r >> 4) * 2 + (c >> 5), rr = r & 15, cc = c & 31, ob = rr * 64 + cc * 2; return st * 1024 + (ob ^ (((ob >> 9) & 1) << 5)); }
DI void stage_rc(int b, int& R, int& C) { const int st = b / 1024, sb = b % 1024, swz = sb ^ (((sb >> 9) & 1) << 5); R = (st >> 1) * 16 + swz / 64; C = (st & 1) * 32 + (swz % 64) / 2; }
DI int perm32(int rho) { const int n = rho >> 4, i = rho & 15; return 8 * (i >> 2) + 4 * n + (i & 3); }
struct Unit { int pm, pn; };
struct Gemm { const bf16_t* A; const bf16_t* Bt; int M, N, K, lda, ldb; };
struct StaticOrder {
    int nM, nN, nwg, G, c;
    DI void init(int M, int N, int G_, int c_) { nM = M / BM; nN = N / BM; nwg = nM * nN; G = G_; c = c_; }
    DI bool next(int i, Unit& u) const {
        const long L = (long)i * G + c; if (L >= nwg) return false;
        int wgid = (int)L; { const int q = nwg / NXCD, r = nwg % NXCD, xcd = wgid % NXCD, off = wgid / NXCD; wgid = (xcd < r ? xcd * (q + 1) : r * (q + 1) + (xcd - r) * q) + off; }
        const int nig = WGM * nN, gid = wgid / nig, fm = gid * WGM, gsz = (nM - fm) < WGM ? (nM - fm) : WGM;
        u.pm = fm + ((wgid % nig) % gsz); u.pn = (wgid % nig) / gsz; return true;
    }
};
template <class Epi>
DI void gemm_phase(LAS unsigned char* lds, const Gemm g, const StaticOrder& S, const Epi& E) {
    const int tid = tid_opaque(), wid = __builtin_amdgcn_readfirstlane(tid >> 6), lane = tid & 63, wr = wid >> 2, wc = wid & 3, fr = lane & 15, fq = lane >> 4;
    const int K = g.K, nt = K / BK;
    unsigned voffA[2], voffB[2];
#pragma unroll
    for (int i = 0; i < 2; ++i) { int R, C; stage_rc(tid * 16 + i * 8192, R, C); const int Rb = Epi::PERM ? ((R & ~31) + perm32(R & 31)) : R;
        voffA[i] = (unsigned)(R * g.lda + C) * 2u; voffB[i] = (unsigned)(Rb * g.ldb + C) * 2u; }
    const size_t kstep = (size_t)(BK * 2);
    const size_t hA = (size_t)HALF * g.lda * 2, hB = (size_t)HALF * g.ldb * 2, tA = 2 * hA, tB = 2 * hB;
    const unsigned ldsw = (unsigned)wid * 1024u;
    const int aoff = lds_byte(wr * 64 + fr, fq * 8), boff = lds_byte(wc * 32 + fr, fq * 8);
#define PG8_SA(b, h) (((b) * 2 + (h)) * HTB)
#define PG8_SB(b, h) ((4 + (b) * 2 + (h)) * HTB)
#define PG8_STAGE(bufoff, gbase, voff) do { _Pragma("unroll") for (int _i = 0; _i < 2; ++_i) \
        __builtin_amdgcn_global_load_lds((const unsigned*)((const char*)(gbase) + (voff)[_i]), (LAS unsigned*)(lds + (bufoff) + ldsw + _i * 8192), 16, 0, 0); } while (0)
#define PG8_LDA(dst, b, h) do { _Pragma("unroll") for (int m = 0; m < 4; ++m) _Pragma("unroll") for (int k = 0; k < 2; ++k) dst[m][k] = *(const LAS bf16x8*)(lds + PG8_SA(b, h) + aoff + m * 2048 + k * 1024); } while (0)
#define PG8_LDB(dst, b, h) do { _Pragma("unroll") for (int n = 0; n < 2; ++n) _Pragma("unroll") for (int k = 0; k < 2; ++k) dst[n][k] = *(const LAS bf16x8*)(lds + PG8_SB(b, h) + boff + n * 2048 + k * 1024); } while (0)
#define PG8_MMA(ai, bj, At, Bt) do { __builtin_amdgcn_s_setprio(1); _Pragma("unroll") for (int m = 0; m < 4; ++m) _Pragma("unroll") for (int n = 0; n < 2; ++n) _Pragma("unroll") for (int k = 0; k < 2; ++k) \
        acc[ai][bj][m][n] = __builtin_amdgcn_mfma_f32_16x16x32_bf16(Bt[n][k], At[m][k], acc[ai][bj][m][n], 0, 0, 0); __builtin_amdgcn_s_setprio(0); } while (0)
#define PG8_WAIT_V(n) asm volatile("s_waitcnt vmcnt(" #n ")" ::: "memory")
#define PG8_WAIT_L(n) asm volatile("s_waitcnt lgkmcnt(" #n ")" ::: "memory")
#define PG8_BAR __builtin_amdgcn_s_barrier()
#define PG8_SCHED __builtin_amdgcn_sched_barrier(0)
    Unit cur, nxt; int ui = 0;
    if (!S.next(0, cur)) return;
    f32x4 acc[2][2][4][2];
#pragma unroll
    for (int a = 0; a < 2; ++a)
#pragma unroll
        for (int b = 0; b < 2; ++b)
#pragma unroll
            for (int m = 0; m < 4; ++m)
#pragma unroll
                for (int n = 0; n < 2; ++n) acc[a][b][m][n] = (f32x4){0.f, 0.f, 0.f, 0.f};
    bf16x8 At[4][2], B0[2][2], B1[2][2];
    const char* cA = (const char*)g.A + (size_t)cur.pm * tA; const char* cB = (const char*)g.Bt + (size_t)cur.pn * tB;
    PG8_STAGE(PG8_SB(0, 0), cB, voffB); PG8_STAGE(PG8_SB(0, 1), cB + hB, voffB); PG8_STAGE(PG8_SA(0, 0), cA, voffA); PG8_STAGE(PG8_SA(0, 1), cA + hA, voffA);
    if (wr == 1) PG8_BAR;
    PG8_WAIT_V(2); PG8_BAR;
    PG8_STAGE(PG8_SB(1, 0), cB + kstep, voffB); PG8_STAGE(PG8_SA(1, 0), cA + kstep, voffA); PG8_STAGE(PG8_SB(1, 1), cB + hB + kstep, voffB);
    PG8_WAIT_V(6); PG8_BAR;
    for (;;) {
        const bool has_next = S.next(ui + 1, nxt);
        const char* nA = has_next ? (const char*)g.A + (size_t)nxt.pm * tA : cA; const char* nB = has_next ? (const char*)g.Bt + (size_t)nxt.pn * tB : cB;
        constexpr int NSEG = Epi::MID ? 2 : 1;
#pragma unroll 1
        for (int sg = 0; sg < NSEG; ++sg) {
        const int tbeg = sg * (nt / NSEG), tend = (sg + 1) * (nt / NSEG);
#pragma unroll 1
        for (int t = tbeg; t < tend; t += 2) {
            const bool last = (t == nt - 2);
            const char* a1 = cA + (size_t)(t + 1) * kstep;
            const char* a2 = last ? nA : cA + (size_t)(t + 2) * kstep; const char* b2 = last ? nB : cB + (size_t)(t + 2) * kstep;
            const char* a3 = a2 + kstep; const char* b3 = b2 + kstep;
            const bool post_epi = (t == 0) && (ui > 0);
            PG8_LDB(B0, 0, 0); PG8_LDB(B1, 0, 1); PG8_SCHED; PG8_LDA(At, 0, 0); PG8_STAGE(PG8_SA(1, 1), a1 + hA, voffA);
            if (post_epi) PG8_WAIT_V(24); else PG8_WAIT_V(8);
            PG8_WAIT_L(0); PG8_BAR; PG8_MMA(0, 0, At, B0); PG8_MMA(0, 1, At, B1); PG8_BAR; PG8_SCHED;
            PG8_LDA(At, 0, 1); PG8_STAGE(PG8_SB(0, 0), b2, voffB); PG8_STAGE(PG8_SB(0, 1), b2 + hB, voffB); PG8_STAGE(PG8_SA(0, 0), a2, voffA);
            if (post_epi) PG8_WAIT_V(24); else PG8_WAIT_V(8);
            PG8_WAIT_L(0); PG8_BAR; PG8_MMA(1, 0, At, B0); PG8_MMA(1, 1, At, B1); PG8_BAR; PG8_SCHED;
            PG8_LDB(B0, 1, 0); PG8_LDB(B1, 1, 1); PG8_SCHED; PG8_LDA(At, 1, 0); PG8_STAGE(PG8_SA(0, 1), a2 + hA, voffA);
            PG8_WAIT_V(8); PG8_WAIT_L(0); PG8_BAR; PG8_MMA(0, 0, At, B0); PG8_MMA(0, 1, At, B1); PG8_BAR; PG8_SCHED;
            PG8_LDA(At, 1, 1); PG8_STAGE(PG8_SB(1, 0), b3, voffB); PG8_STAGE(PG8_SB(1, 1), b3 + hB, voffB); PG8_STAGE(PG8_SA(1, 0), a3, voffA);
            PG8_WAIT_V(8); PG8_WAIT_L(0); PG8_BAR; PG8_MMA(1, 0, At, B0); PG8_MMA(1, 1, At, B1); PG8_BAR; PG8_SCHED;
        }
        if constexpr (Epi::MID) { if (sg == 0) E.mid(acc, cur, wr, wc, fr, fq); }
        }
        if (wr == 0) PG8_BAR;
        E(acc, cur, wr, wc, fr, fq);
        if (!has_next) break;
#pragma unroll
        for (int a = 0; a < 2; ++a)
#pragma unroll
            for (int b = 0; b < 2; ++b)
#pragma unroll
                for (int m = 0; m < 4; ++m)
#pragma unroll
                    for (int n = 0; n < 2; ++n) acc[a][b][m][n] = (f32x4){0.f, 0.f, 0.f, 0.f};
        cur = nxt; cA = nA; cB = nB; ++ui;
        if (wr == 1) PG8_BAR;
    }
    PG8_WAIT_V(0);
    PG8_BAR;
#undef PG8_SA
#undef PG8_SB
#undef PG8_STAGE
#undef PG8_LDA
#undef PG8_LDB
#undef PG8_MMA
#undef PG8_WAIT_V
#undef PG8_WAIT_L
#undef PG8_BAR
#undef PG8_SCHED
}
}
typedef f32x4 AccT[2][2][4][2];

template <int ACT>
struct EpiBf16S {
    static constexpr bool PERM = true, MID = false; static constexpr int MID_T = -1;
    bf16_t* O; int ldc;
    DI void mid(AccT&, const pg8::Unit&, int, int, int, int) const {}
    DI void operator()(const AccT& acc, const pg8::Unit& u, int wr, int wc, int fr, int fq) const {
        const int row0 = u.pm * 256 + wr * 64 + fr, col0 = u.pn * 256 + wc * 32 + 8 * fq;
#pragma unroll
        for (int ai = 0; ai < 2; ++ai)
#pragma unroll
            for (int m = 0; m < 4; ++m) { bf16_t* rowp = O + (size_t)(row0 + ai * 128 + m * 16) * ldc + col0;
#pragma unroll
                for (int bj = 0; bj < 2; ++bj) { f32x4 v0 = acc[ai][bj][m][0], v1 = acc[ai][bj][m][1];
                    if (ACT == 1) {
#pragma unroll
                        for (int j = 0; j < 4; ++j) { const float a = fmaxf(v0[j], 0.f), b = fmaxf(v1[j], 0.f); v0[j] = a * a; v1[j] = b * b; } }
                    u32x4 w; w.x = pk2(v0[0], v0[1]); w.y = pk2(v0[2], v0[3]); w.z = pk2(v1[0], v1[1]); w.w = pk2(v1[2], v1[3]);
                    __builtin_nontemporal_store(w, (u32x4*)(rowp + bj * 128)); } }
    }
};
DI float sig_den(float g) { return 1.f + __expf(fminf(-g, 30.f)); }
struct EpiMerge {
    static constexpr bool PERM = true, MID = true; static constexpr int MID_T = 32;
    bf16_t* P;
    DI void mid(AccT& acc, const pg8::Unit& u, int wr, int wc, int fr, int fq) const {
        int row0 = u.pm * 256 + wr * 64 + fr; const int col0 = u.pn * 256 + wc * 32 + 8 * fq;
        asm volatile("" : "+v"(row0));
#pragma unroll
        for (int ai = 0; ai < 2; ++ai)
#pragma unroll
            for (int m = 0; m < 4; ++m) { const bf16_t* rowp = P + (unsigned)((row0 + ai * 128 + m * 16) * NP + col0);
#pragma unroll
                for (int bj = 0; bj < 2; ++bj) { const u32x4 gg = *(const u32x4*)(rowp + C_GG + bj * 128), gs = *(const u32x4*)(rowp + C_GS + bj * 128);
                    f32x4 ra, rb;
#pragma unroll
                    for (int q = 0; q < 2; ++q) { ra[2 * q] = sig_den(bflo(gs[q])) * __builtin_amdgcn_rcpf(sig_den(bflo(gg[q]))); ra[2 * q + 1] = sig_den(bfhi(gs[q])) * __builtin_amdgcn_rcpf(sig_den(bfhi(gg[q])));
                        rb[2 * q] = sig_den(bflo(gs[q + 2])) * __builtin_amdgcn_rcpf(sig_den(bflo(gg[q + 2]))); rb[2 * q + 1] = sig_den(bfhi(gs[q + 2])) * __builtin_amdgcn_rcpf(sig_den(bfhi(gg[q + 2]))); }
                    acc[ai][bj][m][0] *= ra; acc[ai][bj][m][1] *= rb;
                    asm volatile("" ::: "memory"); } }
    }
    DI void operator()(const AccT& acc, const pg8::Unit& u, int wr, int wc, int fr, int fq) const {
        int row0 = u.pm * 256 + wr * 64 + fr; const int col0 = u.pn * 256 + wc * 32 + 8 * fq;
        asm volatile("" : "+v"(row0));
#pragma unroll
        for (int ai = 0; ai < 2; ++ai)
#pragma unroll
            for (int m = 0; m < 4; ++m) { bf16_t* rowp = P + (unsigned)((row0 + ai * 128 + m * 16) * NP + col0);
#pragma unroll
                for (int bj = 0; bj < 2; ++bj) { const u32x4 gs = *(const u32x4*)(rowp + C_GS + bj * 128); u32x4 w;
#pragma unroll
                    for (int q = 0; q < 4; ++q) { const float s0 = __builtin_amdgcn_rcpf(sig_den(bflo(gs[q]))), s1 = __builtin_amdgcn_rcpf(sig_den(bfhi(gs[q])));
                        w[q] = pk2(acc[ai][bj][m][q >> 1][(q & 1) * 2] * s0, acc[ai][bj][m][q >> 1][(q & 1) * 2 + 1] * s1); }
                    *(u32x4*)(rowp + C_GG + bj * 128) = w; }
                asm volatile("" ::: "memory"); }
    }
};
struct EpiResF32 {
    static constexpr bool PERM = false, MID = false; static constexpr int MID_T = -1;
    const float* res; int ldr; float* out; int ldo;
    DI void mid(AccT&, const pg8::Unit&, int, int, int, int) const {}
    DI void operator()(const AccT& acc, const pg8::Unit& u, int wr, int wc, int fr, int fq) const {
        const int row0 = u.pm * 256 + wr * 64 + fr, col0 = u.pn * 256 + wc * 32 + 4 * fq;
#pragma unroll
        for (int ai = 0; ai < 2; ++ai)
#pragma unroll
            for (int m = 0; m < 4; ++m) { const size_t row = (size_t)(row0 + ai * 128 + m * 16); const float* rp = res + row * ldr + col0; float* op = out + row * ldo + col0;
#pragma unroll
                for (int bj = 0; bj < 2; ++bj)
#pragma unroll
                    for (int n = 0; n < 2; ++n) { const f32x4 rv = *(const f32x4*)(rp + bj * 128 + n * 16); *(f32x4*)(op + bj * 128 + n * 16) = rv * ALPHA + acc[ai][bj][m][n]; }
                asm volatile("" ::: "memory"); }
    }
};

struct EpiResBf {
    static constexpr bool PERM = false, MID = false; static constexpr int MID_T = -1;
    const bf16_t* res; int ldr; float* out; int ldo;
    DI void mid(AccT&, const pg8::Unit&, int, int, int, int) const {}
    DI void operator()(const AccT& acc, const pg8::Unit& u, int wr, int wc, int fr, int fq) const {
        const int row0 = u.pm * 256 + wr * 64 + fr, col0 = u.pn * 256 + wc * 32 + 4 * fq;
#pragma unroll
        for (int ai = 0; ai < 2; ++ai)
#pragma unroll
            for (int m = 0; m < 4; ++m) { const size_t row = (size_t)(row0 + ai * 128 + m * 16); const bf16_t* rp = res + row * ldr + col0; float* op = out + row * ldo + col0;
#pragma unroll
                for (int bj = 0; bj < 2; ++bj)
#pragma unroll
                    for (int n = 0; n < 2; ++n) { const u32x2 rw = *(const u32x2*)(rp + bj * 128 + n * 16); const f32x4 rv = {bflo(rw.x), bfhi(rw.x), bflo(rw.y), bfhi(rw.y)};
                        *(f32x4*)(op + bj * 128 + n * 16) = rv * ALPHA + acc[ai][bj][m][n]; }
                asm volatile("" ::: "memory"); }
    }
};

template <bool RESBF>
struct EpiResOutBf {
    static constexpr bool PERM = true, MID = false; static constexpr int MID_T = -1;
    const void* res; int ldr; bf16_t* out; int ldo;
    DI void mid(AccT&, const pg8::Unit&, int, int, int, int) const {}
    DI void operator()(const AccT& acc, const pg8::Unit& u, int wr, int wc, int fr, int fq) const {
        int row0 = u.pm * 256 + wr * 64 + fr; const int col0 = u.pn * 256 + wc * 32 + 8 * fq;
        asm volatile("" : "+v"(row0));
#pragma unroll
        for (int ai = 0; ai < 2; ++ai)
#pragma unroll
            for (int m = 0; m < 4; ++m) { const unsigned row = (unsigned)(row0 + ai * 128 + m * 16); bf16_t* op = out + (size_t)row * ldo + col0;
#pragma unroll
                for (int bj = 0; bj < 2; ++bj) { f32x4 r0, r1;
                    if (RESBF) { const u32x4 rw = *(const u32x4*)((const bf16_t*)res + (size_t)row * ldr + col0 + bj * 128); r0 = (f32x4){bflo(rw.x), bfhi(rw.x), bflo(rw.y), bfhi(rw.y)}; r1 = (f32x4){bflo(rw.z), bfhi(rw.z), bflo(rw.w), bfhi(rw.w)}; }
                    else { const float* rp = (const float*)res + (size_t)row * ldr + col0 + bj * 128; r0 = *(const f32x4*)rp; r1 = *(const f32x4*)(rp + 4); }
                    const f32x4 v0 = r0 * ALPHA + acc[ai][bj][m][0], v1 = r1 * ALPHA + acc[ai][bj][m][1];
                    u32x4 w; w.x = pk2(v0[0], v0[1]); w.y = pk2(v0[2], v0[3]); w.z = pk2(v1[0], v1[1]); w.w = pk2(v1[2], v1[3]);
                    *(u32x4*)(op + bj * 128) = w; }
                asm volatile("" ::: "memory"); }
    }
};

struct Args {
    const float *x, *w_in, *w_alpha_up, *b_alpha, *gla_norm_w, *attn_sinks, *w_branch_gla, *w_branch_swa, *w_out, *ln1_g, *ln1_b, *w_ff_up, *w_ff_down, *ln2_g, *ln2_b;
    float* out; unsigned char* ws;
};

struct WItem { const float* src; bf16_t* dst; int ldw, ldt; };
DI WItem witem(const Args& a, int it) {
    bf16_t* WinT = (bf16_t*)(a.ws + WS_WIN); bf16_t* WabT = (bf16_t*)(a.ws + WS_WAB); bf16_t* WoT = (bf16_t*)(a.ws + WS_WO); bf16_t* WupT = (bf16_t*)(a.ws + WS_WUP); bf16_t* WdnT = (bf16_t*)(a.ws + WS_WDN);
    constexpr int J0 = 32 * 192, J1 = 32 * 208, J3 = 32 * 64, J6 = 32 * 256;
    const float* W; int ldw, sc0, nblk, ldt, dr0 = 0, dk0 = 0; bf16_t* WT; int r = it;
    if (r < J0) { W = a.w_in; ldw = 12816; sc0 = 0; nblk = 192; WT = WinT; ldt = 2048; }
    else if ((r -= J0) < J1) { W = a.w_in; ldw = 12816; sc0 = 6160; nblk = 208; WT = WinT; ldt = 2048; dr0 = 6144; }
    else if ((r -= J1) < J3) { W = a.w_branch_gla; ldw = 2048; sc0 = 0; nblk = 64; WT = WabT; ldt = 4096; }
    else if ((r -= J3) < J3) { W = a.w_branch_swa; ldw = 2048; sc0 = 0; nblk = 64; WT = WabT; ldt = 4096; dk0 = 2048; }
    else if ((r -= J3) < J3) { W = a.w_out; ldw = 2048; sc0 = 0; nblk = 64; WT = WoT; ldt = 2048; }
    else if ((r -= J3) < J6) { W = a.w_ff_up; ldw = 8192; sc0 = 0; nblk = 256; WT = WupT; ldt = 2048; }
    else { r -= J6; W = a.w_ff_down; ldw = 2048; sc0 = 0; nblk = 64; WT = WdnT; ldt = 8192; }
    const int k0 = 64 * (r / nblk), n0 = 32 * (r % nblk);
    WItem w; w.src = W + (size_t)k0 * ldw + sc0 + n0; w.dst = WT + (size_t)(dr0 + n0) * ldt + dk0 + k0; w.ldw = ldw; w.ldt = ldt; return w;
}
DI void phase_weights(const Args& a, LAS unsigned char* lds, int G) {
    const int tid = tid_opaque(), lane = tid & 63, wave = tid >> 6;
    LAS float* scr = (LAS float*)(lds + wave * 8448);
    bf16_t* W16T = (bf16_t*)(a.ws + WS_W16);
    const int gw = blockIdx.x * 8 + wave, NGW = G * 8;
    constexpr int NIT = 32 * 192 + 32 * 208 + 3 * 32 * 64 + 32 * 256 + 128 * 64;
    float cur[32];
    int it = gw;
    if (it < NIT) { const WItem w = witem(a, it);
#pragma unroll
        for (int i = 0; i < 32; ++i) cur[i] = w.src[(size_t)(2 * i + (lane >> 5)) * w.ldw + (lane & 31)]; }
    for (; it < NIT; it += NGW) {
        const WItem w = witem(a, it);
#pragma unroll
        for (int i = 0; i < 32; ++i) scr[(2 * i + (lane >> 5)) * 33 + (lane & 31)] = cur[i];
        if (it + NGW < NIT) { const WItem wn = witem(a, it + NGW);
#pragma unroll
            for (int i = 0; i < 32; ++i) cur[i] = wn.src[(size_t)(2 * i + (lane >> 5)) * wn.ldw + (lane & 31)]; }
        asm volatile("s_waitcnt lgkmcnt(0)" ::: "memory");
        const int c = lane & 7;
#pragma unroll
        for (int j = 0; j < 4; ++j) { const int n = (lane >> 3) + 8 * j; const LAS float* sp = scr + (8 * c) * 33 + n;
            u32x4 o; o.x = pk2(sp[0 * 33], sp[1 * 33]); o.y = pk2(sp[2 * 33], sp[3 * 33]); o.z = pk2(sp[4 * 33], sp[5 * 33]); o.w = pk2(sp[6 * 33], sp[7 * 33]);
            *(u32x4*)(w.dst + (size_t)n * w.ldt + 8 * c) = o; }
        asm volatile("s_waitcnt lgkmcnt(0)" ::: "memory");
    }
    for (int idx = blockIdx.x * 512 + tid; idx < 32768; idx += G * 512) { const int k = idx >> 4, n = idx & 15; W16T[n * 2048 + k] = f2bf(a.w_in[(size_t)k * 12816 + 6144 + n]); }
}
DI void phase_x(const Args& a, int G) {
    const int tid = tid_opaque(), lane = tid & 63, wave = tid >> 6, fr = lane & 15, fq = lane >> 4;
    bf16_t* XB = (bf16_t*)a.out; const bf16_t* W16T = (const bf16_t*)(a.ws + WS_W16); float* GLR = (float*)(a.ws + WS_GLR);
    const int gw = blockIdx.x * 8 + wave, NGW = G * 8;
    for (int tile = gw; tile < T / 16; tile += NGW) {
        const int r0 = tile * 16;
        const float* xp = a.x + (size_t)(r0 + fr) * D + 8 * fq; bf16_t* xbp = XB + (size_t)(r0 + fr) * D + 8 * fq; const bf16_t* wp = W16T + fr * 2048 + 8 * fq;
        f32x4 acc = {0.f, 0.f, 0.f, 0.f};
        f32x4 xa[8], xb[8]; bf16x8 wa[4], wb[4];
#define X_LOAD(XV, WV, kb) do { _Pragma("unroll") for (int i = 0; i < 4; ++i) { const int ks = 4 * (kb) + i; XV[2 * i] = *(const f32x4*)(xp + 32 * ks); XV[2 * i + 1] = *(const f32x4*)(xp + 32 * ks + 4); WV[i] = *(const bf16x8*)(wp + 32 * ks); } } while (0)
#define X_PROC(XV, WV, kb) do { _Pragma("unroll") for (int i = 0; i < 4; ++i) { const int ks = 4 * (kb) + i; const f32x4 v0 = XV[2 * i], v1 = XV[2 * i + 1]; \
            u32x4 p; p.x = pk2(v0[0], v0[1]); p.y = pk2(v0[2], v0[3]); p.z = pk2(v1[0], v1[1]); p.w = pk2(v1[2], v1[3]); \
            *(u32x4*)(xbp + 32 * ks) = p; acc = MFMA16(__builtin_bit_cast(bf16x8, p), WV[i], acc); } } while (0)
        X_LOAD(xa, wa, 0);
#pragma unroll 1
        for (int kb = 0; kb < 16; kb += 2) {
            X_LOAD(xb, wb, kb + 1);
            X_PROC(xa, wa, kb);
            if (kb + 2 < 16) X_LOAD(xa, wa, kb + 2);
            X_PROC(xb, wb, kb + 1);
        }
#undef X_LOAD
#undef X_PROC
#pragma unroll
        for (int i = 0; i < 4; ++i) GLR[(size_t)(r0 + 4 * fq + i) * 16 + fr] = acc[i];
    }
}
DI float log_sigmoid_f(float z) { return fminf(z, 0.f) - __logf(1.f + __expf(-fabsf(z))); }
DI void phase_gla_prep(const Args& a, LAS unsigned char* lds, int G, bool dry) {
    const int tid = tid_opaque(), lane = tid & 63, wave = tid >> 6, d = tid & 255, sh = tid >> 8, r = lane & 31, hh = lane >> 5;
    bf16_t* P = (bf16_t*)(a.ws + WS_PROJ); const float* GLR = (const float*)(a.ws + WS_GLR); bf16_t* SC = (bf16_t*)(a.ws + WS_SC); float* DEC = (float*)(a.ws + WS_DEC);
    LAS float* glr_s = (LAS float*)lds; LAS float* tot = (LAS float*)(lds + 4096);
    LAS bf16_t* QI = (LAS bf16_t*)(lds + 8192); LAS bf16_t* KI = (LAS bf16_t*)(lds + 8192 + 33792); LAS bf16_t* KT = (LAS bf16_t*)(lds + 8192 + 2 * 33792);
    for (int u = blockIdx.x; u < 2048; u += G) {
        const int b = u >> 10, n = (u & 1023) >> 2, h = u & 3, t0 = b * SEQ + n * 64;
        if (tid < 256) ((LAS f32x4*)glr_s)[tid] = ((const f32x4*)(GLR + (size_t)t0 * 16))[tid];
#pragma unroll
        for (int i = 0; i < 4; ++i) { const int c = tid + 512 * i, row = c >> 5, c16 = c & 31; const bf16_t* src = P + (size_t)(t0 + row) * NP + h * 256 + c16 * 8;
            *(LAS u32x4*)(QI + row * 264 + c16 * 8) = *(const u32x4*)(src + C_GQ); *(LAS u32x4*)(KI + row * 264 + c16 * 8) = *(const u32x4*)(src + C_GK); }
        float wu[16];
#pragma unroll
        for (int j = 0; j < 16; ++j) wu[j] = a.w_alpha_up[j * 1024 + h * 256 + d];
        const float ba = a.b_alpha[h * 256 + d];
        __syncthreads();
        float cs[32];
        { float cum = 0.f;
#pragma unroll
          for (int s = 0; s < 32; ++s) { const LAS float* gp = glr_s + (sh * 32 + s) * 16; float z = ba;
#pragma unroll
              for (int j = 0; j < 16; ++j) z += gp[j] * wu[j];
              cum += log_sigmoid_f(z) * 0.0625f; cs[s] = cum; }
          tot[sh * 256 + d] = cum; }
        __syncthreads();
        const float t0v = tot[d], t1v = tot[256 + d], blast = t0v + t1v, coff = sh ? t0v : 0.f;
        LAS unsigned* kt32 = (LAS unsigned*)KT;
#pragma unroll
        for (int s2 = 0; s2 < 16; ++s2) { float kd[2];
#pragma unroll
            for (int e = 0; e < 2; ++e) { const int s = sh * 32 + 2 * s2 + e; const float cum = cs[2 * s2 + e] + coff;
                const float q = bf2f(QI[s * 264 + d]), k = bf2f(KI[s * 264 + d]);
                QI[s * 264 + d] = f2bf(q * 0.0625f * __expf(cum)); KI[s * 264 + d] = f2bf(k * __expf(-cum)); kd[e] = k * __expf(blast - cum); }
            kt32[d * 36 + sh * 16 + s2] = pk2(kd[0], kd[1]); }
        __syncthreads();
        if (wave < 4) { const int mt = wave >> 1, nt = wave & 1; f32x16 acc;
#pragma unroll
            for (int i = 0; i < 16; ++i) acc[i] = 0.f;
#pragma unroll 4
            for (int ks = 0; ks < 16; ++ks) { const bf16x8 av = *(const LAS bf16x8*)(QI + (32 * mt + r) * 264 + 16 * ks + 8 * hh), bv = *(const LAS bf16x8*)(KI + (32 * nt + r) * 264 + 16 * ks + 8 * hh);
                acc = MFMA32(av, bv, acc); }
            bf16_t* scp = redir(SC + (size_t)u * 4096, dry, a.ws);
#pragma unroll
            for (int i = 0; i < 16; ++i) { const int sq = 32 * mt + crow(i, hh), sk = 32 * nt + r; scp[sq * 64 + sk] = f2bf(sk <= sq ? acc[i] : 0.f); } }
#pragma unroll
        for (int i = 0; i < 4; ++i) { const int c = tid + 512 * i, row = c >> 5, c16 = c & 31;
            *(u32x4*)redir(P + (size_t)(t0 + row) * NP + C_GQ + h * 256 + c16 * 8, dry, a.ws) = *(const LAS u32x4*)(QI + row * 264 + c16 * 8); }
        { bf16_t* dst = redir(P + (size_t)(t0 + (d >> 2)) * NP + C_GK + h * 256 + (d & 3) * 64 + sh * 32, dry, a.ws);
#pragma unroll
          for (int i = 0; i < 4; ++i) *(u32x4*)(dst + 8 * i) = *(const LAS u32x4*)(KT + d * 72 + sh * 32 + 8 * i); }
        if (sh == 0) *redir(DEC + (size_t)u * 256 + d, dry, a.ws) = expf(blast);
        __syncthreads();
    }
}
DI bf16x8 pack8(const f32x16& x, int s) {
    u32x4 p; p.x = pk2(x[8 * s], x[8 * s + 1]); p.y = pk2(x[8 * s + 2], x[8 * s + 3]); p.z = pk2(x[8 * s + 4], x[8 * s + 5]); p.w = pk2(x[8 * s + 6], x[8 * s + 7]);
    return __builtin_bit_cast(bf16x8, p);
}
DI bf16x8 ld2x8(const LAS bf16_t* p) { const u32x2 lo = *(const LAS u32x2*)p, hi = *(const LAS u32x2*)(p + 8); u32x4 v; v.x = lo.x; v.y = lo.y; v.z = hi.x; v.w = hi.y; return __builtin_bit_cast(bf16x8, v); }
DI unsigned bfsel(const u32x4& v, int j) { const unsigned w = v[j >> 1]; return (j & 1) ? (w >> 16) : (w & 0xffffu); }
template <bool FULL, bool NOLOAD = false>
DI void phase_gla_scan(const Args& a, LAS unsigned char* lds, int stream, int seg, bool dry) {
    const int tid = tid_opaque(), lane = tid & 63, wave = tid >> 6, r = lane & 31, hh = lane >> 5, wm = wave >> 1, wn = wave & 1;
    const int bh = stream >> 3, b = bh >> 2, h = bh & 3, sl = stream & 7, dv0 = sl * 64, nbeg = seg * 64;
    bf16_t* P = (bf16_t*)(a.ws + WS_PROJ); const bf16_t* SC = (const bf16_t*)(a.ws + WS_SC); const float* DEC = (const float*)(a.ws + WS_DEC); float* SSQ = (float*)(a.ws + WS_SSQ);
    float* LG = (float*)(a.ws + WS_LG); float* DG = (float*)(a.ws + WS_DG);
    LAS bf16_t* QIs = (LAS bf16_t*)lds; LAS bf16_t* KDs = (LAS bf16_t*)(lds + 33792); LAS bf16_t* VTs = (LAS bf16_t*)(lds + 70656);
    LAS bf16_t* SCs = (LAS bf16_t*)(lds + 79872); LAS float* DECs = (LAS float*)(lds + 89088); LAS float* PART = (LAS float*)lds;
    f32x16 S0, S1;
#pragma unroll
    for (int i = 0; i < 16; ++i) { S0[i] = 0.f; S1[i] = 0.f; }
    if (FULL) {
        for (int gg = 0; gg < seg; ++gg) { const float* lp = LG + ((size_t)(stream * 4 + gg) * 512 + tid) * 32; const float* dp = DG + (size_t)(stream * 4 + gg) * 256 + 64 * wm;
#pragma unroll
            for (int i4 = 0; i4 < 4; ++i4) { const f32x4 l0 = *(const f32x4*)(lp + 4 * i4), l1 = *(const f32x4*)(lp + 16 + 4 * i4);
#pragma unroll
                for (int e = 0; e < 4; ++e) { const int i = 4 * i4 + e; S0[i] = S0[i] * dp[crow(i, hh)] + l0[e]; S1[i] = S1[i] * dp[32 + crow(i, hh)] + l1[e]; } } }
    }
    float dprod = 1.f;
    u32x4 pq[4], pk[4], pva, pvb, psc, pdec;
    const int ldrow = tid >> 5, ldc16 = tid & 31, vp = tid & 31, vg8 = (tid >> 5) & 7, scrow = tid >> 3, scc8 = tid & 7;
#define SCAN_LOAD(nn) do { const int t0_ = b * SEQ + (nn) * 64, u_ = b * 1024 + (nn) * 4 + h; \
        _Pragma("unroll") for (int i = 0; i < 4; ++i) { const bf16_t* src = P + (size_t)(t0_ + ldrow + 16 * i) * NP + h * 256 + ldc16 * 8; if (FULL) pq[i] = *(const u32x4*)(src + C_GQ); pk[i] = *(const u32x4*)(src + C_GK); } \
        { const bf16_t* src = P + (size_t)(t0_ + 2 * vp) * NP + C_GV + h * 512 + dv0 + vg8 * 8; pva = *(const u32x4*)src; pvb = *(const u32x4*)(src + NP); } \
        if (FULL) psc = *(const u32x4*)(SC + (size_t)u_ * 4096 + scrow * 64 + scc8 * 8); \
        pdec = ((const u32x4*)(DEC + (size_t)u_ * 256))[tid & 63]; } while (0)
    SCAN_LOAD(nbeg);
#pragma unroll 1
    for (int n = nbeg; n < nbeg + 64; ++n) {
        const int t0 = b * SEQ + n * 64;
        LBAR();
#pragma unroll
        for (int i = 0; i < 4; ++i) { const int row = ldrow + 16 * i;
            if (FULL) *(LAS u32x4*)(QIs + row * 264 + ldc16 * 8) = pq[i];
            *(LAS u32x4*)(KDs + (4 * row + (ldc16 >> 3)) * 72 + (ldc16 & 7) * 8) = pk[i]; }
        if (tid < 256) { LAS unsigned* vt32 = (LAS unsigned*)VTs;
#pragma unroll
            for (int j = 0; j < 8; ++j) vt32[(vg8 * 8 + j) * 36 + vp] = bfsel(pva, j) | (bfsel(pvb, j) << 16); }
        if (FULL) *(LAS u32x4*)(SCs + scrow * 72 + scc8 * 8) = psc;
        if (tid < 64) ((LAS u32x4*)DECs)[tid] = pdec;
        if (!NOLOAD) { if (n + 1 < nbeg + 64) SCAN_LOAD(n + 1); }
        LBAR();
        f32x16 o0, o1;
        if (FULL) {
#pragma unroll
            for (int i = 0; i < 16; ++i) { o0[i] = 0.f; o1[i] = 0.f; }
#pragma unroll
            for (int tl = 0; tl < 2; ++tl)
#pragma unroll
                for (int s2 = 0; s2 < 2; ++s2) { const bf16x8 bfrag = pack8(tl ? S1 : S0, s2); const int dkb = 64 * wm + 32 * tl + 16 * s2 + 4 * hh;
                    o0 = MFMA32(ld2x8(QIs + r * 264 + dkb), bfrag, o0); o1 = MFMA32(ld2x8(QIs + (32 + r) * 264 + dkb), bfrag, o1); }
            { const bf16x8 bv = *(const LAS bf16x8*)(VTs + (32 * wn + r) * 72 + 16 * wm + 8 * hh);
              o0 = MFMA32(*(const LAS bf16x8*)(SCs + r * 72 + 16 * wm + 8 * hh), bv, o0); o1 = MFMA32(*(const LAS bf16x8*)(SCs + (32 + r) * 72 + 16 * wm + 8 * hh), bv, o1); }
        } else { if (tid < 256) dprod *= DECs[tid]; }
#pragma unroll
        for (int i = 0; i < 16; ++i) { S0[i] *= DECs[64 * wm + crow(i, hh)]; S1[i] *= DECs[64 * wm + 32 + crow(i, hh)]; }
#pragma unroll
        for (int ks = 0; ks < 4; ++ks) { const bf16x8 bv = *(const LAS bf16x8*)(VTs + (32 * wn + r) * 72 + 16 * ks + 8 * hh);
            S0 = MFMA32(*(const LAS bf16x8*)(KDs + (64 * wm + r) * 72 + 16 * ks + 8 * hh), bv, S0);
            S1 = MFMA32(*(const LAS bf16x8*)(KDs + (64 * wm + 32 + r) * 72 + 16 * ks + 8 * hh), bv, S1); }
        if (FULL) {
            LBAR();
#pragma unroll
            for (int i = 0; i < 16; ++i) { PART[(wm * 64 + crow(i, hh)) * 68 + 32 * wn + r] = o0[i]; PART[(wm * 64 + 32 + crow(i, hh)) * 68 + 32 * wn + r] = o1[i]; }
            LBAR();
            { const int s = tid >> 3, c8 = tid & 7; f32x4 a0 = {0.f, 0.f, 0.f, 0.f}, a1 = a0;
#pragma unroll
              for (int w4 = 0; w4 < 4; ++w4) { const LAS float* pp = PART + (w4 * 64 + s) * 68 + c8 * 8; a0 += *(const LAS f32x4*)pp; a1 += *(const LAS f32x4*)(pp + 4); }
              float ssq = a0[0] * a0[0] + a0[1] * a0[1] + a0[2] * a0[2] + a0[3] * a0[3] + a1[0] * a1[0] + a1[1] * a1[1] + a1[2] * a1[2] + a1[3] * a1[3];
              ssq += __shfl_xor(ssq, 1); ssq += __shfl_xor(ssq, 2); ssq += __shfl_xor(ssq, 4);
              if (c8 == 0) *redir(SSQ + (size_t)(t0 + s) * 32 + h * 8 + sl, dry, a.ws) = ssq;
              u32x4 w; w.x = pk2(a0[0], a0[1]); w.y = pk2(a0[2], a0[3]); w.z = pk2(a1[0], a1[1]); w.w = pk2(a1[2], a1[3]);
              *(u32x4*)redir(P + (size_t)(t0 + s) * NP + C_GV + h * 512 + dv0 + c8 * 8, dry, a.ws) = w; }
        }
    }
#undef SCAN_LOAD
    if (!FULL) {
        float* lp = LG + ((size_t)(stream * 4 + seg) * 512 + tid) * 32;
#pragma unroll
        for (int i4 = 0; i4 < 4; ++i4) { *(f32x4*)(lp + 4 * i4) = (f32x4){S0[4 * i4], S0[4 * i4 + 1], S0[4 * i4 + 2], S0[4 * i4 + 3]}; *(f32x4*)(lp + 16 + 4 * i4) = (f32x4){S1[4 * i4], S1[4 * i4 + 1], S1[4 * i4 + 2], S1[4 * i4 + 3]}; }
        if (tid < 256) DG[(size_t)(stream * 4 + seg) * 256 + tid] = dprod;
    }
}
DI void phase_gla_scan_p1(const Args& a, LAS unsigned char* lds, int stream, int seg) {
    const int tid = tid_opaque(), lane = tid & 63, wave = tid >> 6, r = lane & 31, hh = lane >> 5, wm = wave >> 1, wn = wave & 1;
    const int bh = stream >> 3, b = bh >> 2, h = bh & 3, sl = stream & 7, dv0 = sl * 64, nbeg = seg * 64;
    const bf16_t* P = (const bf16_t*)(a.ws + WS_PROJ); const float* DEC = (const float*)(a.ws + WS_DEC);
    float* LG = (float*)(a.ws + WS_LG); float* DG = (float*)(a.ws + WS_DG);
    LAS bf16_t* KDs = (LAS bf16_t*)(lds + 33792); LAS bf16_t* VTs = (LAS bf16_t*)(lds + 70656); LAS float* DECs = (LAS float*)(lds + 89088);
    f32x16 S0, S1;
#pragma unroll
    for (int i = 0; i < 16; ++i) { S0[i] = 0.f; S1[i] = 0.f; }
    float dprod = 1.f;
    const int ldrow = tid >> 5, ldc16 = tid & 31, vp = tid & 31, vg8 = (tid >> 5) & 7;
    const bf16_t* kbase = P + (size_t)(b * SEQ + ldrow) * NP + C_GK + h * 256 + ldc16 * 8;
    const bf16_t* vbase = P + (size_t)(b * SEQ + 2 * vp) * NP + C_GV + h * 512 + dv0 + vg8 * 8;
    const float* dbase = DEC + (size_t)(b * 1024 + h) * 256 + (tid & 63) * 4;
    u32x4 ak[4], ava, avb, adec, bk[4], bva, bvb, bdec;
#define P1_LOAD(K_, VA_, VB_, D_, nn) do { const size_t ro_ = (size_t)(nn) * 64 * NP; \
        _Pragma("unroll") for (int i = 0; i < 4; ++i) K_[i] = *(const u32x4*)(kbase + ro_ + (size_t)(16 * i) * NP); \
        VA_ = *(const u32x4*)(vbase + ro_); VB_ = *(const u32x4*)(vbase + ro_ + NP); D_ = *(const u32x4*)(dbase + (size_t)(nn) * 1024); } while (0)
#define P1_STEP(K_, VA_, VB_, D_, nnext) do { \
        LBAR(); \
        _Pragma("unroll") for (int i = 0; i < 4; ++i) { const int row = ldrow + 16 * i; *(LAS u32x4*)(KDs + (4 * row + (ldc16 >> 3)) * 72 + (ldc16 & 7) * 8) = K_[i]; } \
        if (tid < 256) { LAS unsigned* vt32 = (LAS unsigned*)VTs; _Pragma("unroll") for (int j = 0; j < 8; ++j) vt32[(vg8 * 8 + j) * 36 + vp] = bfsel(VA_, j) | (bfsel(VB_, j) << 16); } \
        if (tid < 64) ((LAS u32x4*)DECs)[tid] = D_; \
        if ((nnext) < nbeg + 64) P1_LOAD(K_, VA_, VB_, D_, (nnext)); \
        LBAR(); \
        if (tid < 256) dprod *= DECs[tid]; \
        _Pragma("unroll") for (int i = 0; i < 16; ++i) { S0[i] *= DECs[64 * wm + crow(i, hh)]; S1[i] *= DECs[64 * wm + 32 + crow(i, hh)]; } \
        _Pragma("unroll") for (int ks = 0; ks < 4; ++ks) { const bf16x8 bv = *(const LAS bf16x8*)(VTs + (32 * wn + r) * 72 + 16 * ks + 8 * hh); \
            S0 = MFMA32(*(const LAS bf16x8*)(KDs + (64 * wm + r) * 72 + 16 * ks + 8 * hh), bv, S0); \
            S1 = MFMA32(*(const LAS bf16x8*)(KDs + (64 * wm + 32 + r) * 72 + 16 * ks + 8 * hh), bv, S1); } } while (0)
    P1_LOAD(ak, ava, avb, adec, nbeg); P1_LOAD(bk, bva, bvb, bdec, nbeg + 1);
#pragma unroll 1
    for (int n = nbeg; n < nbeg + 64; n += 2) { P1_STEP(ak, ava, avb, adec, n + 2); P1_STEP(bk, bva, bvb, bdec, n + 3); }
#undef P1_LOAD
#undef P1_STEP
    float* lp = LG + ((size_t)(stream * 4 + seg) * 512 + tid) * 32;
#pragma unroll
    for (int i4 = 0; i4 < 4; ++i4) { *(f32x4*)(lp + 4 * i4) = (f32x4){S0[4 * i4], S0[4 * i4 + 1], S0[4 * i4 + 2], S0[4 * i4 + 3]}; *(f32x4*)(lp + 16 + 4 * i4) = (f32x4){S1[4 * i4], S1[4 * i4 + 1], S1[4 * i4 + 2], S1[4 * i4 + 3]}; }
    if (tid < 256) DG[(size_t)(stream * 4 + seg) * 256 + tid] = dprod;
}
DI void phase_swa(const Args& a, LAS unsigned char* lds, int ubeg, int ustep, int uend, bool dry) {
    const int tid = tid_opaque(), lane = tid & 63, wave = tid >> 6, r = lane & 31, hh = lane >> 5;
    bf16_t* P = (bf16_t*)(a.ws + WS_PROJ);
    LAS bf16_t* Ks = (LAS bf16_t*)lds; LAS bf16_t* VT = (LAS bf16_t*)(lds + 36864); LAS unsigned* VT32 = (LAS unsigned*)(lds + 36864);
    for (int u = ubeg; u < uend; u += ustep) {
        const int b = u >> 9, nb = (u & 511) >> 2, kh = u & 3, tq0 = b * SEQ + 128 * nb, tk0 = tq0 - 128;
        __syncthreads();
#pragma unroll
        for (int i = 0; i < 4; ++i) { const int c = tid + 512 * i, key = c >> 3, c8 = c & 7; u32x4 v = {0u, 0u, 0u, 0u};
            if (nb > 0 || key >= 128) v = *(const u32x4*)(P + (size_t)(tk0 + key) * NP + C_SK + kh * 64 + c8 * 8);
            *(LAS u32x4*)(Ks + key * 72 + c8 * 8) = v; }
#pragma unroll
        for (int i = 0; i < 2; ++i) { const int task = tid + 512 * i, p = task & 127, g8 = task >> 7; u32x4 va = {0u, 0u, 0u, 0u}, vb = va;
            if (nb > 0 || p >= 64) { const bf16_t* src = P + (size_t)(tk0 + 2 * p) * NP + C_SV + kh * 64 + g8 * 8; va = *(const u32x4*)src; vb = *(const u32x4*)(src + NP); }
#pragma unroll
            for (int j = 0; j < 8; ++j) VT32[(g8 * 8 + j) * 130 + p] = bfsel(va, j) | (bfsel(vb, j) << 16); }
        __syncthreads();
        const int hq = kh * 8 + wave; const float slope = exp2f(-0.25f * (float)(hq + 1)), sink = a.attn_sinks[hq];
        const float sl2 = slope * 1.4426950408889634f, c0l2 = 0.125f * 1.4426950408889634f, sink2 = sink * 1.4426950408889634f;
        bf16x8 bq[4];
        { const bf16_t* q0 = P + (size_t)(tq0 + r) * NP + C_SQ + hq * 64;
#pragma unroll
          for (int ks = 0; ks < 4; ++ks) bq[ks] = *(const bf16x8*)(q0 + 16 * ks + 8 * hh); }
#pragma unroll 1
        for (int j = 0; j < 4; ++j) {
            const size_t tq = (size_t)(tq0 + 32 * j + r);
            bf16_t* qrow = P + tq * NP + C_SQ + hq * 64;
            f32x16 st[5];
#pragma unroll
            for (int kt = 0; kt < 5; ++kt) { f32x16 acc;
#pragma unroll
                for (int i = 0; i < 16; ++i) acc[i] = 0.f;
#pragma unroll
                for (int ks = 0; ks < 4; ++ks) acc = MFMA32(*(const LAS bf16x8*)(Ks + (32 * (j + kt) + r) * 72 + 16 * ks + 8 * hh), bq[ks], acc);
                st[kt] = acc; }
            if (j < 3) { const bf16_t* qn = qrow + (size_t)32 * NP;
#pragma unroll
                for (int ks = 0; ks < 4; ++ks) bq[ks] = *(const bf16x8*)(qn + 16 * ks + 8 * hh); }
            float l;
            int b2 = r + 128 - 4 * hh; asm volatile("" : "+v"(b2));
            if (nb > 0) {
                const float sb = sl2 * (float)b2; float m = sink2;
#pragma unroll
                for (int kt = 0; kt < 5; ++kt)
#pragma unroll
                    for (int i = 0; i < 16; ++i) { const int cc = 32 * kt + (i & 3) + 8 * (i >> 2); float lg = fmaf(st[kt][i], c0l2, fmaf(sl2, (float)cc, -sb));
                        if (kt == 0) lg = (b2 - cc < 128) ? lg : -1e30f;
                        if (kt == 4) lg = (b2 - cc >= 0) ? lg : -1e30f;
                        st[kt][i] = lg; m = fmaxf(m, lg); }
                m = fmaxf(m, __shfl_xor(m, 32));
                l = 0.f;
#pragma unroll
                for (int kt = 0; kt < 5; ++kt)
#pragma unroll
                    for (int i = 0; i < 16; ++i) { const float p = __builtin_amdgcn_exp2f(st[kt][i] - m); st[kt][i] = p; l += p; }
                l += __shfl_xor(l, 32); l += __builtin_amdgcn_exp2f(sink2 - m);
            } else {
                float m = sink;
                const int minkf2 = (128 - 32 * j) - 4 * hh;
#pragma unroll
                for (int kt = 0; kt < 5; ++kt)
#pragma unroll
                    for (int i = 0; i < 16; ++i) { const int cc = 32 * kt + (i & 3) + 8 * (i >> 2), dist = b2 - cc; const bool valid = ((unsigned)dist < 128u) && (cc >= minkf2);
                        const float lg = valid ? st[kt][i] * 0.125f - slope * (float)dist : -1e30f; st[kt][i] = lg; m = fmaxf(m, lg); }
                m = fmaxf(m, __shfl_xor(m, 32));
                l = 0.f;
#pragma unroll
                for (int kt = 0; kt < 5; ++kt)
#pragma unroll
                    for (int i = 0; i < 16; ++i) { const float p = __expf(st[kt][i] - m); st[kt][i] = p; l += p; }
                l += __shfl_xor(l, 32); l += __expf(sink - m);
            }
            const float inv = 1.f / l;
            f32x16 oa, ob;
#pragma unroll
            for (int i = 0; i < 16; ++i) { oa[i] = 0.f; ob[i] = 0.f; }
#pragma unroll
            for (int kt = 0; kt < 5; ++kt)
#pragma unroll
                for (int s2 = 0; s2 < 2; ++s2) { const bf16x8 bfrag = pack8(st[kt], s2); const int keyb = 32 * (j + kt) + 16 * s2 + 4 * hh;
                    oa = MFMA32(ld2x8(VT + r * 260 + keyb), bfrag, oa); ob = MFMA32(ld2x8(VT + (32 + r) * 260 + keyb), bfrag, ob); }
#pragma unroll
            for (int i4 = 0; i4 < 4; ++i4) { const int d0 = 8 * i4 + 4 * hh; u32x2 w0, w1;
                w0.x = pk2(oa[4 * i4] * inv, oa[4 * i4 + 1] * inv); w0.y = pk2(oa[4 * i4 + 2] * inv, oa[4 * i4 + 3] * inv);
                w1.x = pk2(ob[4 * i4] * inv, ob[4 * i4 + 1] * inv); w1.y = pk2(ob[4 * i4 + 2] * inv, ob[4 * i4 + 3] * inv);
                *(u32x2*)redir(qrow + d0, dry, a.ws) = w0; *(u32x2*)redir(qrow + 32 + d0, dry, a.ws) = w1; }
        }
    }
}
DI void phase_gla_norm(const Args& a, int G, bool dry) {
    const int tid = tid_opaque(), lane = tid & 63, wave = tid >> 6;
    bf16_t* P = (bf16_t*)(a.ws + WS_PROJ); const float* SSQ = (const float*)(a.ws + WS_SSQ);
    const f32x4 w0 = *(const f32x4*)(a.gla_norm_w + lane * 8), w1 = *(const f32x4*)(a.gla_norm_w + lane * 8 + 4);
    const float wv[8] = {w0[0], w0[1], w0[2], w0[3], w1[0], w1[1], w1[2], w1[3]};
    u32x4 o8[4], g8[4]; f32x4 sq[8];
#define NORM_LOAD(tt) do { const bf16_t* rp_ = P + (size_t)(tt) * NP + lane * 8; \
        _Pragma("unroll") for (int j = 0; j < 4; ++j) { o8[j] = *(const u32x4*)(rp_ + C_GV + j * 512); g8[j] = *(const u32x4*)(rp_ + C_GO + j * 512); \
            sq[2 * j] = *(const f32x4*)(SSQ + (size_t)(tt) * 32 + j * 8); sq[2 * j + 1] = *(const f32x4*)(SSQ + (size_t)(tt) * 32 + j * 8 + 4); } } while (0)
    int t = blockIdx.x * 8 + wave;
    if (t < T) NORM_LOAD(t);
    for (; t < T; t += G * 8) {
        bf16_t* rowp = P + (size_t)t * NP;
        u32x4 wout[4];
#pragma unroll
        for (int j = 0; j < 4; ++j) { const f32x4 s0 = sq[2 * j], s1 = sq[2 * j + 1];
            const float ss = (s0[0] + s0[1]) + (s0[2] + s0[3]) + (s1[0] + s1[1]) + (s1[2] + s1[3]); const float rstd = rsqrtf(ss * (1.f / 512.f) + 1e-6f);
#pragma unroll
            for (int q = 0; q < 4; ++q) { const float ga = bflo(g8[j][q]), gb = bfhi(g8[j][q]);
                const float ra = bflo(o8[j][q]) * rstd * wv[2 * q] * (ga / (1.f + __expf(-ga))), rb = bfhi(o8[j][q]) * rstd * wv[2 * q + 1] * (gb / (1.f + __expf(-gb)));
                wout[j][q] = pk2(ra, rb); } }
        if (t + G * 8 < T) NORM_LOAD(t + G * 8);
#pragma unroll
        for (int j = 0; j < 4; ++j) *(u32x4*)redir(rowp + C_GO + j * 512 + lane * 8, dry, a.ws) = wout[j];
    }
#undef NORM_LOAD
}
template <bool BF, bool F32OUT>
DI void phase_ln(const float* in, int ldi, float* out, int ldo, bf16_t* ob, int ldb, const float* gam, const float* bet, int G, bool dry, unsigned char* ws) {
    const int tid = tid_opaque(), lane = tid & 63, wave = tid >> 6;
    for (int t = blockIdx.x * 8 + wave; t < T; t += G * 8) {
        const float* ip = in + (size_t)t * ldi + lane * 4; f32x4 v[8]; float s = 0.f;
#pragma unroll
        for (int j = 0; j < 8; ++j) { v[j] = *(const f32x4*)(ip + j * 256); s += (v[j][0] + v[j][1]) + (v[j][2] + v[j][3]); }
#pragma unroll
        for (int o = 1; o < 64; o <<= 1) s += __shfl_xor(s, o);
        const float mean = s * (1.f / 2048.f); float q = 0.f;
#pragma unroll
        for (int j = 0; j < 8; ++j) { v[j] = v[j] - mean; q += (v[j][0] * v[j][0] + v[j][1] * v[j][1]) + (v[j][2] * v[j][2] + v[j][3] * v[j][3]); }
#pragma unroll
        for (int o = 1; o < 64; o <<= 1) q += __shfl_xor(q, o);
        const float rstd = rsqrtf(q * (1.f / 2048.f) + 1e-5f);
        float* op = out + (size_t)t * ldo + lane * 4;
#pragma unroll
        for (int j = 0; j < 8; ++j) { const f32x4 gv = *(const f32x4*)(gam + j * 256 + lane * 4), bv = *(const f32x4*)(bet + j * 256 + lane * 4); const f32x4 y = v[j] * rstd * gv + bv;
            if (F32OUT) *(f32x4*)redir(op + j * 256, dry, ws) = y;
            if (BF) { u32x2 w; w.x = pk2(y[0], y[1]); w.y = pk2(y[2], y[3]); *(u32x2*)redir(ob + (size_t)t * ldb + j * 256 + lane * 4, dry, ws) = w; } }
    }
}


template <bool F32OUT>
DI void phase_ln_bf(const bf16_t* in, int ldi, float* outf, int ldo, bf16_t* ob, int ldb, const float* gam, const float* bet, int G, bool dry, unsigned char* ws) {
    const int tid = tid_opaque(), lane = tid & 63, wave = tid >> 6;
    u32x4 nx[4];
    int t = blockIdx.x * 8 + wave;
    if (t < T) {
#pragma unroll
        for (int j = 0; j < 4; ++j) nx[j] = *(const u32x4*)(in + (size_t)t * ldi + lane * 8 + j * 512); }
    for (; t < T; t += G * 8) {
        f32x4 v[8]; float s = 0.f;
#pragma unroll
        for (int j = 0; j < 4; ++j) { const u32x4 w = nx[j]; v[2 * j] = (f32x4){bflo(w.x), bfhi(w.x), bflo(w.y), bfhi(w.y)}; v[2 * j + 1] = (f32x4){bflo(w.z), bfhi(w.z), bflo(w.w), bfhi(w.w)};
            s += ((v[2 * j][0] + v[2 * j][1]) + (v[2 * j][2] + v[2 * j][3])) + ((v[2 * j + 1][0] + v[2 * j + 1][1]) + (v[2 * j + 1][2] + v[2 * j + 1][3])); }
        if (t + G * 8 < T) {
#pragma unroll
            for (int j = 0; j < 4; ++j) nx[j] = *(const u32x4*)(in + (size_t)(t + G * 8) * ldi + lane * 8 + j * 512); }
#pragma unroll
        for (int o = 1; o < 64; o <<= 1) s += __shfl_xor(s, o);
        const float mean = s * (1.f / 2048.f); float q = 0.f;
#pragma unroll
        for (int j = 0; j < 8; ++j) { v[j] = v[j] - mean; q += (v[j][0] * v[j][0] + v[j][1] * v[j][1]) + (v[j][2] * v[j][2] + v[j][3] * v[j][3]); }
#pragma unroll
        for (int o = 1; o < 64; o <<= 1) q += __shfl_xor(q, o);
        const float rstd = rsqrtf(q * (1.f / 2048.f) + 1e-5f);
#pragma unroll
        for (int j = 0; j < 4; ++j) { const int col = j * 512 + lane * 8;
            const f32x4 g0 = *(const f32x4*)(gam + col), g1 = *(const f32x4*)(gam + col + 4), b0 = *(const f32x4*)(bet + col), b1 = *(const f32x4*)(bet + col + 4);
            const f32x4 y0 = v[2 * j] * rstd * g0 + b0, y1 = v[2 * j + 1] * rstd * g1 + b1;
            if (F32OUT) { float* op = outf + (size_t)t * ldo + col; *(f32x4*)redir(op, dry, ws) = y0; *(f32x4*)redir(op + 4, dry, ws) = y1; }
            else { u32x4 w; w.x = pk2(y0[0], y0[1]); w.y = pk2(y0[2], y0[3]); w.z = pk2(y1[0], y1[1]); w.w = pk2(y1[2], y1[3]); *(u32x4*)redir(ob + (size_t)t * ldb + col, dry, ws) = w; } }
    }
}

#define XB_TMO      128
#define XB_XCNT(j)  (256  + 64 * (j))
#define XB_XSUB(j)  (1280 + 64 * (j))
#define XB_XGEN(j)  (2304 + 64 * (j))
#define XB_TOP      3328
#define XB_TOPGEN   3392
#define XCD_BAR_WORDS 3456
#define XB_SPIN_CAP (1u << 18)
DI unsigned xb_ld(unsigned* p)              { return __hip_atomic_load(p, __ATOMIC_RELAXED, __HIP_MEMORY_SCOPE_AGENT); }
DI unsigned xb_add(unsigned* p, unsigned v) { return __hip_atomic_fetch_add(p, v, __ATOMIC_RELAXED, __HIP_MEMORY_SCOPE_AGENT); }
DI unsigned xb_xcc_id() { return (unsigned)__builtin_amdgcn_s_getreg((3 << 11) | 20) & 0xFu; }
#define XB_SPIN(cond, bar) do { unsigned _sp = 0; while (cond) { __builtin_amdgcn_s_sleep(1); \
    if ((++_sp & 255u) == 0u) { if (xb_ld(&(bar)[XB_TMO])) break; if (_sp > XB_SPIN_CAP) { atomicAdd(&(bar)[XB_TMO], 1u); break; } } } } while (0)
struct XcdBarrier { unsigned* bar; unsigned x; volatile LAS unsigned* st; };
DI XcdBarrier xcd_barrier_post(unsigned* bar, volatile LAS unsigned* st) {
    XcdBarrier b; b.bar = bar; b.x = xb_xcc_id(); b.st = st;
    if (threadIdx.x == 0) (void)xb_add(&bar[XB_XCNT(b.x)], 1u);
    return b;
}
DI void xcd_barrier_complete(unsigned* bar, unsigned x, unsigned& nloc, unsigned& nx) {
    const unsigned G = gridDim.x * gridDim.y * gridDim.z;
    unsigned sum, cnt, mine, sp = 0u;
    for (;;) {
        sum = 0u; cnt = 0u; mine = 0u;
#pragma unroll
        for (unsigned j = 0; j < 16; ++j) { const unsigned c = xb_ld(&bar[XB_XCNT(j)]); sum += c; cnt += (c > 0u) ? 1u : 0u; mine = (j == x) ? c : mine; }
        if (sum == G) break;
        __builtin_amdgcn_s_sleep(1);
        if ((++sp & 255u) == 0u) { if (xb_ld(&bar[XB_TMO])) break; if (sp > XB_SPIN_CAP) { atomicAdd(&bar[XB_TMO], 1u); break; } }
    }
    nloc = mine > 0u ? mine : 1u; nx = cnt > 0u ? cnt : 1u;
}
DI void xcd_barrier(const XcdBarrier& b) {
    asm volatile("s_waitcnt vmcnt(0)" ::: "memory");
    __syncthreads();
    if (threadIdx.x == 0) {
        unsigned* bar = b.bar;
        __builtin_amdgcn_s_waitcnt(0);
        unsigned nloc = b.st[0], nx = b.st[1];
        if (nloc == 0u) { xcd_barrier_complete(bar, b.x, nloc, nx); b.st[0] = nloc; b.st[1] = nx; }
        const unsigned old = xb_add(&bar[XB_XSUB(b.x)], 1u);
        const unsigned gen = old / nloc;
        if (old + 1u == (gen + 1u) * nloc) {
            __builtin_amdgcn_fence(__ATOMIC_RELEASE, "agent");
            asm volatile("s_waitcnt vmcnt(0)" ::: "memory");
            const unsigned og = xb_add(&bar[XB_TOP], 1u);
            const unsigned tg = og / nx;
            if (og + 1u == (tg + 1u) * nx) xb_add(&bar[XB_TOPGEN], 1u);
            else XB_SPIN(xb_ld(&bar[XB_TOPGEN]) == tg, bar);
            __builtin_amdgcn_fence(__ATOMIC_ACQUIRE, "agent");
            xb_add(&bar[XB_XGEN(b.x)], 1u);
            asm volatile("s_waitcnt vmcnt(0)" ::: "memory");
        } else {
            XB_SPIN(xb_ld(&bar[XB_XGEN(b.x)]) == gen, bar);
            __builtin_amdgcn_fence(__ATOMIC_ACQUIRE, "agent");
            asm volatile("s_waitcnt vmcnt(0)" ::: "memory");
        }
    }
    __syncthreads();
}

__global__ void __launch_bounds__(512, 2) mega(Args a) {
    extern __shared__ __attribute__((aligned(16))) unsigned char lds_raw[];
    LAS unsigned char* lds = (LAS unsigned char*)lds_raw;
    cg::grid_group grid = cg::this_grid();
    const int G = gridDim.x;
    { volatile LAS unsigned* st0 = (volatile LAS unsigned*)(lds + 131072 + 32); if (threadIdx.x == 0) { st0[0] = 0u; st0[1] = 0u; } __syncthreads(); }
    XcdBarrier xbar = xcd_barrier_post((unsigned*)(a.ws + WS_CTL), (volatile LAS unsigned*)(lds + 131072 + 32));
#define GSYNC() xcd_barrier(xbar)
    bf16_t* P = (bf16_t*)(a.ws + WS_PROJ);
    bf16_t* XB = (bf16_t*)a.out;
    float* V1 = (float*)(a.ws + WS_PROJ);

    if (a.ws == nullptr) grid.sync();
    phase_weights(a, lds, G);
    GSYNC();
    if (PROBE & 1024) { for (int i = 0; i < 20; ++i) GSYNC(); }
    phase_x(a, G);
    GSYNC();
    if (PROBE & 64) { phase_weights(a, lds, G); GSYNC(); phase_x(a, G); GSYNC(); }
    {
        pg8::Gemm g{XB, (const bf16_t*)(a.ws + WS_WIN), T, NP, D, D, D}; pg8::StaticOrder S; S.init(T, NP, G, (int)blockIdx.x);
        EpiBf16S<0> E{P, NP}; pg8::gemm_phase(lds, g, S, E);
        if (PROBE & 1) { GSYNC(); pg8::gemm_phase(lds, g, S, E); }
    }
    GSYNC();
    if (PROBE & 4) { phase_gla_prep(a, lds, G, true); GSYNC(); }
    phase_gla_prep(a, lds, G, false);
    GSYNC();
    {
        const int blk = (int)blockIdx.x, xcd = blk & 7, jx = blk >> 3, q = xcd * 4 + (jx >> 3), seg = q >> 3, stream = (q & 7) * 8 + (jx & 7);
        if (PROBE & 8) { if (seg < 3) phase_gla_scan<false>(a, lds, stream, seg, false); else phase_swa(a, lds, (xcd - 6) * 32 + jx, 64, SWA_A, true);
            GSYNC(); phase_gla_scan<true>(a, lds, stream, seg, true); phase_swa(a, lds, SWA_A + blk, G, 1024, true); GSYNC(); }
        if (PROBE & 16) { if (seg < 3) phase_gla_scan<false>(a, lds, stream, seg, false); GSYNC(); }
        if (PROBE & 256) { phase_gla_scan<true>(a, lds, stream, seg, true); GSYNC(); }
        if (PROBE & 512) { phase_swa(a, lds, blk, G, 1024, true); GSYNC(); }
        if (seg < 3) phase_gla_scan_p1(a, lds, stream, seg); else phase_swa(a, lds, (xcd - 6) * 32 + jx, 64, SWA_A, false);
        GSYNC();
        phase_gla_scan<true>(a, lds, stream, seg, false);
        phase_swa(a, lds, SWA_A + blk, G, 1024, false);
    }
    GSYNC();
    if (PROBE & 32) { phase_gla_norm(a, G, true); GSYNC(); }
    phase_gla_norm(a, G, false);
    GSYNC();
    {
        pg8::Gemm g{P + C_GO, (const bf16_t*)(a.ws + WS_WAB), T, D, 2 * D, NP, 2 * D}; pg8::StaticOrder S; S.init(T, D, G, (int)blockIdx.x);
        EpiMerge E{P}; pg8::gemm_phase(lds, g, S, E);
    }
    GSYNC();
    {
        pg8::Gemm g{P + C_GG, (const bf16_t*)(a.ws + WS_WO), T, D, D, NP, D}; pg8::StaticOrder S; S.init(T, D, G, (int)blockIdx.x);
        EpiResOutBf<false> E{a.x, D, P, NP}; pg8::gemm_phase(lds, g, S, E);
        if (PROBE & 2) { GSYNC(); pg8::gemm_phase(lds, g, S, E); }
    }
    GSYNC();
    if (PROBE & 128) { phase_ln_bf<false>(P, NP, nullptr, 0, P, NP, a.ln1_g, a.ln1_b, G, true, a.ws); GSYNC(); }
    phase_ln_bf<false>(P, NP, nullptr, 0, P, NP, a.ln1_g, a.ln1_b, G, false, a.ws);
    GSYNC();
    {
        pg8::Gemm g{P, (const bf16_t*)(a.ws + WS_WUP), T, DFF, D, NP, D}; pg8::StaticOrder S; S.init(T, DFF, G, (int)blockIdx.x);
        EpiBf16S<1> E{P + C_H, NP}; pg8::gemm_phase(lds, g, S, E);
        if (PROBE & 2) { GSYNC(); pg8::gemm_phase(lds, g, S, E); }
    }
    GSYNC();
    {
        pg8::Gemm g{P + C_H, (const bf16_t*)(a.ws + WS_WDN), T, D, DFF, NP, DFF}; pg8::StaticOrder S; S.init(T, D, G, (int)blockIdx.x);
        EpiResOutBf<true> E{P, NP, P + C_GV, NP}; pg8::gemm_phase(lds, g, S, E);
        if (PROBE & 2) { GSYNC(); pg8::gemm_phase(lds, g, S, E); }
    }
    GSYNC();
    if (PROBE & 128) { phase_ln_bf<true>(P + C_GV, NP, a.out, D, nullptr, 0, a.ln2_g, a.ln2_b, G, true, a.ws); GSYNC(); }
    phase_ln_bf<true>(P + C_GV, NP, a.out, D, nullptr, 0, a.ln2_g, a.ln2_b, G, false, a.ws);
}

extern "C" void kernel_launch(void* const* d_in, const int* in_sizes, int n_in, void* d_out, int out_size, void* d_ws, size_t ws_size, hipStream_t stream) {
    static int grid = 0;
    if (grid == 0) {
        if (n_in != 15 || in_sizes[0] != T * D || out_size != T * D || ws_size < WS_END) { fprintf(stderr, "kernel_launch: unexpected shapes / workspace (%zu)\n", ws_size); grid = -1; return; }
        int dev = 0, cus = 0, per_cu = 0;
        hipGetDevice(&dev); hipDeviceGetAttribute(&cus, hipDeviceAttributeMultiprocessorCount, dev);
        hipFuncSetAttribute((const void*)mega, hipFuncAttributeMaxDynamicSharedMemorySize, LDS_BYTES);
        hipOccupancyMaxActiveBlocksPerMultiprocessor(&per_cu, (const void*)mega, 512, LDS_BYTES);
        if (per_cu < 1) { fprintf(stderr, "kernel_launch: occupancy 0\n"); per_cu = 1; }
        grid = cus;
        if (grid != 256) { fprintf(stderr, "kernel_launch: built for 256 CUs\n"); grid = -1; return; }
    }
    if (grid < 0) return;
    if (hipMemsetAsync((char*)d_ws + WS_CTL, 0, 65536, stream) != hipSuccess) { fprintf(stderr, "kernel_launch: memset failed\n"); return; }
    Args a{};
    a.x = (const float*)d_in[0]; a.w_in = (const float*)d_in[1]; a.w_alpha_up = (const float*)d_in[2]; a.b_alpha = (const float*)d_in[3];
    a.gla_norm_w = (const float*)d_in[4]; a.attn_sinks = (const float*)d_in[5]; a.w_branch_gla = (const float*)d_in[6]; a.w_branch_swa = (const float*)d_in[7];
    a.w_out = (const float*)d_in[8]; a.ln1_g = (const float*)d_in[9]; a.ln1_b = (const float*)d_in[10]; a.w_ff_up = (const float*)d_in[11];
    a.w_ff_down = (const float*)d_in[12]; a.ln2_g = (const float*)d_in[13]; a.ln2_b = (const float*)d_in[14];
    a.out = (float*)d_out; a.ws = (unsigned char*)d_ws;
    void* args[] = {&a};
    hipError_t e = hipLaunchCooperativeKernel((const void*)mega, dim3(grid), dim3(512), args, LDS_BYTES, stream);
    if (e != hipSuccess) fprintf(stderr, "cooperative launch failed: %s (grid %d)\n", hipGetErrorString(e), grid);
}
```

```cpp
#include <hip/hip_runtime.h>
#include <hip/hip_cooperative_groups.h>
#include <cstdio>
#include <cstdint>
namespace cg = cooperative_groups;

#define DI __device__ __forceinline__
#define LAS __attribute__((address_space(3)))
typedef unsigned short bf16_t;
typedef short bf16x8 __attribute__((ext_vector_type(8)));
typedef float f32x4 __attribute__((ext_vector_type(4)));
typedef float f32x2 __attribute__((ext_vector_type(2)));
typedef float f32x16 __attribute__((ext_vector_type(16)));
typedef unsigned u32x4 __attribute__((ext_vector_type(4)));
typedef unsigned u32x2 __attribute__((ext_vector_type(2)));
typedef __bf16 bf16v2 __attribute__((ext_vector_type(2)));

DI unsigned pk2(float lo, float hi) { f32x2 v = {lo, hi}; bf16v2 b = __builtin_convertvector(v, bf16v2); return __builtin_bit_cast(unsigned, b); }
DI bf16_t f2bf(float f) { return (bf16_t)(pk2(f, 0.f) & 0xffffu); }
DI float bflo(unsigned w) { return __uint_as_float(w << 16); }
DI float bfhi(unsigned w) { return __uint_as_float(w & 0xffff0000u); }
DI float bf2f(bf16_t b) { return __uint_as_float(((unsigned)b) << 16); }
DI int tid_opaque() { int t = threadIdx.x; asm volatile("" : "+v"(t)); return t; }
template <class Tp> DI Tp* redir(Tp* p, bool dry, unsigned char* ws) { return dry ? (Tp*)(ws + 984 * (size_t)1048576 + ((size_t)p & 0xFFFFF0)) : p; }
#define LBAR() do { asm volatile("s_waitcnt lgkmcnt(0)" ::: "memory"); __builtin_amdgcn_s_barrier(); asm volatile("" ::: "memory"); } while (0)
DI int crow(int i, int h) { return (i & 3) + 8 * (i >> 2) + 4 * h; }
#define MFMA32(a, b, c) __builtin_amdgcn_mfma_f32_32x32x16_bf16((a), (b), (c), 0, 0, 0)
#define MFMA16(a, b, c) __builtin_amdgcn_mfma_f32_16x16x32_bf16((a), (b), (c), 0, 0, 0)

constexpr int T = 32768, SEQ = 16384, D = 2048, NP = 12800, DFF = 8192;
constexpr int C_GQ = 0, C_GK = 1024, C_GV = 2048, C_GO = 4096, C_SQ = 6144, C_SK = 8192, C_SV = 8448, C_GG = 8704, C_GS = 10752, C_H = 4096;
constexpr float ALPHA = 1.189207115002721f;
constexpr size_t MiB = 1u << 20;
constexpr size_t WS_PROJ = 0, WS_WIN = 800 * MiB, WS_WAB = 850 * MiB, WS_WO = 866 * MiB, WS_WUP = 874 * MiB, WS_WDN = 906 * MiB,
                 WS_GLR = 938 * MiB, WS_W16 = 940 * MiB, WS_SC = 941 * MiB, WS_DEC = 957 * MiB, WS_SSQ = 959 * MiB, WS_LG = 964 * MiB, WS_DG = 981 * MiB, WS_CTL = 982 * MiB, WS_END = 1001 * MiB;
constexpr int LDS_BYTES = 131072 + 1024;
constexpr int NSCAN = 64, SWA_A = 256;
#ifndef PROBE
#define PROBE 0
#endif

namespace pg8 {
constexpr int BM = 256, BK = 64, HALF = 128, HTB = HALF * BK * 2, STAGE_BYTES = 8 * HTB, NXCD = 8, WGM = 8;
DI int lds_byte(int r, int c) { const int st = (r >> 4) * 2 + (c >> 5), rr = r & 15, cc = c & 31, ob = rr * 64 + cc * 2; return st * 1024 + (ob ^ (((ob >> 9) & 1) << 5)); }
DI void stage_rc(int b, int& R, int& C) { const int st = b / 1024, sb = b % 1024, swz = sb ^ (((sb >> 9) & 1) << 5); R = (st >> 1) * 16 + swz / 64; C = (st & 1) * 32 + (swz % 64) / 2; }
DI int perm32(int rho) { const int n = rho >> 4, i = rho & 15; return 8 * (i >> 2) + 4 * n + (i & 3); }
struct Unit { int pm, pn; };
struct Gemm { const bf16_t* A; const bf16_t* Bt; int M, N, K, lda, ldb; };
struct StaticOrder {
    int nM, nN, nwg, G, c;
    DI void init(int M, int N, int G_, int c_) { nM = M / BM; nN = N / BM; nwg = nM * nN; G = G_; c = c_; }
    DI bool next(int i, Unit& u) const {
        const long L = (long)i * G + c; if (L >= nwg) return false;
        int wgid = (int)L; { const int q = nwg / NXCD, r = nwg % NXCD, xcd = wgid % NXCD, off = wgid / NXCD; wgid = (xcd < r ? xcd * (q + 1) : r * (q + 1) + (xcd - r) * q) + off; }
        const int nig = WGM * nN, gid = wgid / nig, fm = gid * WGM, gsz = (nM - fm) < WGM ? (nM - fm) : WGM;
        u.pm = fm + ((wgid % nig) % gsz); u.pn = (wgid % nig) / gsz; return true;
    }
};
template <class Epi>
DI void gemm_phase(LAS unsigned char* lds, const Gemm g, const StaticOrder& S, const Epi& E) {
    const int tid = tid_opaque(), wid = __builtin_amdgcn_readfirstlane(tid >> 6), lane = tid & 63, wr = wid >> 2, wc = wid & 3, fr = lane & 15, fq = lane >> 4;
    const int K = g.K, nt = K / BK;
    unsigned voffA[2], voffB[2];
#pragma unroll
    for (int i = 0; i < 2; ++i) { int R, C; stage_rc(tid * 16 + i * 8192, R, C); const int Rb = Epi::PERM ? ((R & ~31) + perm32(R & 31)) : R;
        voffA[i] = (unsigned)(R * g.lda + C) * 2u; voffB[i] = (unsigned)(Rb * g.ldb + C) * 2u; }
    const size_t kstep = (size_t)(BK * 2);
    const size_t hA = (size_t)HALF * g.lda * 2, hB = (size_t)HALF * g.ldb * 2, tA = 2 * hA, tB = 2 * hB;
    const unsigned ldsw = (unsigned)wid * 1024u;
    const int aoff = lds_byte(wr * 64 + fr, fq * 8), boff = lds_byte(wc * 32 + fr, fq * 8);
#define PG8_SA(b, h) (((b) * 2 + (h)) * HTB)
#define PG8_SB(b, h) ((4 + (b) * 2 + (h)) * HTB)
#define PG8_STAGE(bufoff, gbase, voff) do { _Pragma("unroll") for (int _i = 0; _i < 2; ++_i) \
        __builtin_amdgcn_global_load_lds((const unsigned*)((const char*)(gbase) + (voff)[_i]), (LAS unsigned*)(lds + (bufoff) + ldsw + _i * 8192), 16, 0, 0); } while (0)
#define PG8_LDA(dst, b, h) do { _Pragma("unroll") for (int m = 0; m < 4; ++m) _Pragma("unroll") for (int k = 0; k < 2; ++k) dst[m][k] = *(const LAS bf16x8*)(lds + PG8_SA(b, h) + aoff + m * 2048 + k * 1024); } while (0)
#define PG8_LDB(dst, b, h) do { _Pragma("unroll") for (int n = 0; n < 2; ++n) _Pragma("unroll") for (int k = 0; k < 2; ++k) dst[n][k] = *(const LAS bf16x8*)(lds + PG8_SB(b, h) + boff + n * 2048 + k * 1024); } while (0)
#define PG8_MMA(ai, bj, At, Bt) do { __builtin_amdgcn_s_setprio(1); _Pragma("unroll") for (int m = 0; m < 4; ++m) _Pragma("unroll") for (int n = 0; n < 2; ++n) _Pragma("unroll") for (int k = 0; k < 2; ++k) \
        acc[ai][bj][m][n] = __builtin_amdgcn_mfma_f32_16x16x32_bf16(Bt[n][k], At[m][k], acc[ai][bj][m][n], 0, 0, 0); __builtin_amdgcn_s_setprio(0); } while (0)
#define PG8_WAIT_V(n) asm volatile("s_waitcnt vmcnt(" #n ")" ::: "memory")
#define PG8_WAIT_L(n) asm volatile("s_waitcnt lgkmcnt(" #n ")" ::: "memory")
#define PG8_BAR __builtin_amdgcn_s_barrier()
#define PG8_SCHED __builtin_amdgcn_sched_barrier(0)
    Unit cur, nxt; int ui = 0;
    if (!S.next(0, cur)) return;
    f32x4 acc[2][2][4][2];
#pragma unroll
    for (int a = 0; a < 2; ++a)
#pragma unroll
        for (int b = 0; b < 2; ++b)
#pragma unroll
            for (int m = 0; m < 4; ++m)
#pragma unroll
                for (int n = 0; n < 2; ++n) acc[a][b][m][n] = (f32x4){0.f, 0.f, 0.f, 0.f};
    bf16x8 At[4][2], B0[2][2], B1[2][2];
    const char* cA = (const char*)g.A + (size_t)cur.pm * tA; const char* cB = (const char*)g.Bt + (size_t)cur.pn * tB;
    PG8_STAGE(PG8_SB(0, 0), cB, voffB); PG8_STAGE(PG8_SB(0, 1), cB + hB, voffB); PG8_STAGE(PG8_SA(0, 0), cA, voffA); PG8_STAGE(PG8_SA(0, 1), cA + hA, voffA);
    if (wr == 1) PG8_BAR;
    PG8_WAIT_V(2); PG8_BAR;
    PG8_STAGE(PG8_SB(1, 0), cB + kstep, voffB); PG8_STAGE(PG8_SA(1, 0), cA + kstep, voffA); PG8_STAGE(PG8_SB(1, 1), cB + hB + kstep, voffB);
    PG8_WAIT_V(6); PG8_BAR;
    for (;;) {
        const bool has_next = S.next(ui + 1, nxt);
        const char* nA = has_next ? (const char*)g.A + (size_t)nxt.pm * tA : cA; const char* nB = has_next ? (const char*)g.Bt + (size_t)nxt.pn * tB : cB;
        constexpr int NSEG = Epi::MID ? 2 : 1;
#pragma unroll 1
        for (int sg = 0; sg < NSEG; ++sg) {
        const int tbeg = sg * (nt / NSEG), tend = (sg + 1) * (nt / NSEG);
#pragma unroll 1
        for (int t = tbeg; t < tend; t += 2) {
            const bool last = (t == nt - 2);
            const char* a1 = cA + (size_t)(t + 1) * kstep;
            const char* a2 = last ? nA : cA + (size_t)(t + 2) * kstep; const char* b2 = last ? nB : cB + (size_t)(t + 2) * kstep;
            const char* a3 = a2 + kstep; const char* b3 = b2 + kstep;
            const bool post_epi = (t == 0) && (ui > 0);
            PG8_LDB(B0, 0, 0); PG8_LDB(B1, 0, 1); PG8_SCHED; PG8_LDA(At, 0, 0); PG8_STAGE(PG8_SA(1, 1), a1 + hA, voffA);
            if (post_epi) PG8_WAIT_V(24); else PG8_WAIT_V(8);
            PG8_WAIT_L(0); PG8_BAR; PG8_MMA(0, 0, At, B0); PG8_MMA(0, 1, At, B1); PG8_BAR; PG8_SCHED;
            PG8_LDA(At, 0, 1); PG8_STAGE(PG8_SB(0, 0), b2, voffB); PG8_STAGE(PG8_SB(0, 1), b2 + hB, voffB); PG8_STAGE(PG8_SA(0, 0), a2, voffA);
            if (post_epi) PG8_WAIT_V(24); else PG8_WAIT_V(8);
            PG8_WAIT_L(0); PG8_BAR; PG8_MMA(1, 0, At, B0); PG8_MMA(1, 1, At, B1); PG8_BAR; PG8_SCHED;
            PG8_LDB(B0, 1, 0); PG8_LDB(B1, 1, 1); PG8_SCHED; PG8_LDA(At, 1, 0); PG8_STAGE(PG8_SA(0, 1), a2 + hA, voffA);
            PG8_WAIT_V(8); PG8_WAIT_L(0); PG8_BAR; PG8_MMA(0, 0, At, B0); PG8_MMA(0, 1, At, B1); PG8_BAR; PG8_SCHED;
            PG8_LDA(At, 1, 1); PG8_STAGE(PG8_SB(1, 0), b3, voffB); PG8_STAGE(PG8_SB(1, 1), b3 + hB, voffB); PG8_STAGE(PG8_SA(1, 0), a3, voffA);
            PG8_WAIT_V(8); PG8_WAIT_L(0); PG8_BAR; PG8_MMA(1, 0, At, B0); PG8_MMA(1, 1, At, B1); PG8_BAR; PG8_SCHED;
        }
        if constexpr (Epi::MID) { if (sg == 0) E.mid(acc, cur, wr, wc, fr, fq); }
        }
        if (wr == 0) PG8_BAR;
        E(acc, cur, wr, wc, fr, fq);
        if (!has_next) break;
#pragma unroll
        for (int a = 0; a < 2; ++a)
#pragma unroll
            for (int b = 0; b < 2; ++b)
#pragma unroll
                for (int m = 0; m < 4; ++m)
#pragma unroll
                    for (int n = 0; n < 2; ++n) acc[a][b][m][n] = (f32x4){0.f, 0.f, 0.f, 0.f};
        cur = nxt; cA = nA; cB = nB; ++ui;
        if (wr == 1) PG8_BAR;
    }
    PG8_WAIT_V(0);
    PG8_BAR;
#undef PG8_SA
#undef PG8_SB
#undef PG8_STAGE
#undef PG8_LDA
#undef PG8_LDB
#undef PG8_MMA
#undef PG8_WAIT_V
#undef PG8_WAIT_L
#undef PG8_BAR
#undef PG8_SCHED
}
}
typedef f32x4 AccT[2][2][4][2];

template <int ACT>
struct EpiBf16S {
    static constexpr bool PERM = true, MID = false; static constexpr int MID_T = -1;
    bf16_t* O; int ldc;
    DI void mid(AccT&, const pg8::Unit&, int, int, int, int) const {}
    DI void operator()(const AccT& acc, const pg8::Unit& u, int wr, int wc, int fr, int fq) const {
        const int row0 = u.pm * 256 + wr * 64 + fr, col0 = u.pn * 256 + wc * 32 + 8 * fq;
#pragma unroll
        for (int ai = 0; ai < 2; ++ai)
#pragma unroll
            for (int m = 0; m < 4; ++m) { bf16_t* rowp = O + (size_t)(row0 + ai * 128 + m * 16) * ldc + col0;
#pragma unroll
                for (int bj = 0; bj < 2; ++bj) { f32x4 v0 = acc[ai][bj][m][0], v1 = acc[ai][bj][m][1];
                    if (ACT == 1) {
#pragma unroll
                        for (int j = 0; j < 4; ++j) { const float a = fmaxf(v0[j], 0.f), b = fmaxf(v1[j], 0.f); v0[j] = a * a; v1[j] = b * b; } }
                    u32x4 w; w.x = pk2(v0[0], v0[1]); w.y = pk2(v0[2], v0[3]); w.z = pk2(v1[0], v1[1]); w.w = pk2(v1[2], v1[3]);
                    __builtin_nontemporal_store(w, (u32x4*)(rowp + bj * 128)); } }
    }
};
DI float sig_den(float g) { return 1.f + __expf(fminf(-g, 30.f)); }
struct EpiMerge {
    static constexpr bool PERM = true, MID = true; static constexpr int MID_T = 32;
    bf16_t* P;
    DI void mid(AccT& acc, const pg8::Unit& u, int wr, int wc, int fr, int fq) const {
        int row0 = u.pm * 256 + wr * 64 + fr; const int col0 = u.pn * 256 + wc * 32 + 8 * fq;
        asm volatile("" : "+v"(row0));
#pragma unroll
        for (int ai = 0; ai < 2; ++ai)
#pragma unroll
            for (int m = 0; m < 4; ++m) { const bf16_t* rowp = P + (unsigned)((row0 + ai * 128 + m * 16) * NP + col0);
#pragma unroll
                for (int bj = 0; bj < 2; ++bj) { const u32x4 gg = *(const u32x4*)(rowp + C_GG + bj * 128), gs = *(const u32x4*)(rowp + C_GS + bj * 128);
                    f32x4 ra, rb;
#pragma unroll
                    for (int q = 0; q < 2; ++q) { ra[2 * q] = sig_den(bflo(gs[q])) * __builtin_amdgcn_rcpf(sig_den(bflo(gg[q]))); ra[2 * q + 1] = sig_den(bfhi(gs[q])) * __builtin_amdgcn_rcpf(sig_den(bfhi(gg[q])));
                        rb[2 * q] = sig_den(bflo(gs[q + 2])) * __builtin_amdgcn_rcpf(sig_den(bflo(gg[q + 2]))); rb[2 * q + 1] = sig_den(bfhi(gs[q + 2])) * __builtin_amdgcn_rcpf(sig_den(bfhi(gg[q + 2]))); }
                    acc[ai][bj][m][0] *= ra; acc[ai][bj][m][1] *= rb;
                    asm volatile("" ::: "memory"); } }
    }
    DI void operator()(const AccT& acc, const pg8::Unit& u, int wr, int wc, int fr, int fq) const {
        int row0 = u.pm * 256 + wr * 64 + fr; const int col0 = u.pn * 256 + wc * 32 + 8 * fq;
        asm volatile("" : "+v"(row0));
#pragma unroll
        for (int ai = 0; ai < 2; ++ai)
#pragma unroll
            for (int m = 0; m < 4; ++m) { bf16_t* rowp = P + (unsigned)((row0 + ai * 128 + m * 16) * NP + col0);
#pragma unroll
                for (int bj = 0; bj < 2; ++bj) { const u32x4 gs = *(const u32x4*)(rowp + C_GS + bj * 128); u32x4 w;
#pragma unroll
                    for (int q = 0; q < 4; ++q) { const float s0 = __builtin_amdgcn_rcpf(sig_den(bflo(gs[q]))), s1 = __builtin_amdgcn_rcpf(sig_den(bfhi(gs[q])));
                        w[q] = pk2(acc[ai][bj][m][q >> 1][(q & 1) * 2] * s0, acc[ai][bj][m][q >> 1][(q & 1) * 2 + 1] * s1); }
                    *(u32x4*)(rowp + C_GG + bj * 128) = w; }
                asm volatile("" ::: "memory"); }
    }
};
struct EpiResF32 {
    static constexpr bool PERM = false, MID = false; static constexpr int MID_T = -1;
    const float* res; int ldr; float* out; int ldo;
    DI void mid(AccT&, const pg8::Unit&, int, int, int, int) const {}
    DI void operator()(const AccT& acc, const pg8::Unit& u, int wr, int wc, int fr, int fq) const {
        const int row0 = u.pm * 256 + wr * 64 + fr, col0 = u.pn * 256 + wc * 32 + 4 * fq;
#pragma unroll
        for (int ai = 0; ai < 2; ++ai)
#pragma unroll
            for (int m = 0; m < 4; ++m) { const size_t row = (size_t)(row0 + ai * 128 + m * 16); const float* rp = res + row * ldr + col0; float* op = out + row * ldo + col0;
#pragma unroll
                for (int bj = 0; bj < 2; ++bj)
#pragma unroll
                    for (int n = 0; n < 2; ++n) { const f32x4 rv = *(const f32x4*)(rp + bj * 128 + n * 16); *(f32x4*)(op + bj * 128 + n * 16) = rv * ALPHA + acc[ai][bj][m][n]; }
                asm volatile("" ::: "memory"); }
    }
};

struct EpiResBf {
    static constexpr bool PERM = false, MID = false; static constexpr int MID_T = -1;
    const bf16_t* res; int ldr; float* out; int ldo;
    DI void mid(AccT&, const pg8::Unit&, int, int, int, int) const {}
    DI void operator()(const AccT& acc, const pg8::Unit& u, int wr, int wc, int fr, int fq) const {
        const int row0 = u.pm * 256 + wr * 64 + fr, col0 = u.pn * 256 + wc * 32 + 4 * fq;
#pragma unroll
        for (int ai = 0; ai < 2; ++ai)
#pragma unroll
            for (int m = 0; m < 4; ++m) { const size_t row = (size_t)(row0 + ai * 128 + m * 16); const bf16_t* rp = res + row * ldr + col0; float* op = out + row * ldo + col0;
#pragma unroll
                for (int bj = 0; bj < 2; ++bj)
#pragma unroll
                    for (int n = 0; n < 2; ++n) { const u32x2 rw = *(const u32x2*)(rp + bj * 128 + n * 16); const f32x4 rv = {bflo(rw.x), bfhi(rw.x), bflo(rw.y), bfhi(rw.y)};
                        *(f32x4*)(op + bj * 128 + n * 16) = rv * ALPHA + acc[ai][bj][m][n]; }
                asm volatile("" ::: "memory"); }
    }
};

template <bool RESBF>
struct EpiResOutBf {
    static constexpr bool PERM = true, MID = false; static constexpr int MID_T = -1;
    const void* res; int ldr; bf16_t* out; int ldo;
    DI void mid(AccT&, const pg8::Unit&, int, int, int, int) const {}
    DI void operator()(const AccT& acc, const pg8::Unit& u, int wr, int wc, int fr, int fq) const {
        int row0 = u.pm * 256 + wr * 64 + fr; const int col0 = u.pn * 256 + wc * 32 + 8 * fq;
        asm volatile("" : "+v"(row0));
#pragma unroll
        for (int ai = 0; ai < 2; ++ai)
#pragma unroll
            for (int m = 0; m < 4; ++m) { const unsigned row = (unsigned)(row0 + ai * 128 + m * 16); bf16_t* op = out + (size_t)row * ldo + col0;
#pragma unroll
                for (int bj = 0; bj < 2; ++bj) { f32x4 r0, r1;
                    if (RESBF) { const u32x4 rw = *(const u32x4*)((const bf16_t*)res + (size_t)row * ldr + col0 + bj * 128); r0 = (f32x4){bflo(rw.x), bfhi(rw.x), bflo(rw.y), bfhi(rw.y)}; r1 = (f32x4){bflo(rw.z), bfhi(rw.z), bflo(rw.w), bfhi(rw.w)}; }
                    else { const float* rp = (const float*)res + (size_t)row * ldr + col0 + bj * 128; r0 = *(const f32x4*)rp; r1 = *(const f32x4*)(rp + 4); }
                    const f32x4 v0 = r0 * ALPHA + acc[ai][bj][m][0], v1 = r1 * ALPHA + acc[ai][bj][m][1];
                    u32x4 w; w.x = pk2(v0[0], v0[1]); w.y = pk2(v0[2], v0[3]); w.z = pk2(v1[0], v1[1]); w.w = pk2(v1[2], v1[3]);
                    *(u32x4*)(op + bj * 128) = w; }
                asm volatile("" ::: "memory"); }
    }
};

struct Args {
    const float *x, *w_in, *w_alpha_up, *b_alpha, *gla_norm_w, *attn_sinks, *w_branch_gla, *w_branch_swa, *w_out, *ln1_g, *ln1_b, *w_ff_up, *w_ff_down, *ln2_g, *ln2_b;
    float* out; unsigned char* ws;
};

struct WItem { const float* src; bf16_t* dst; int ldw, ldt; };
DI WItem witem(const Args& a, int it) {
    bf16_t* WinT = (bf16_t*)(a.ws + WS_WIN); bf16_t* WabT = (bf16_t*)(a.ws + WS_WAB); bf16_t* WoT = (bf16_t*)(a.ws + WS_WO); bf16_t* WupT = (bf16_t*)(a.ws + WS_WUP); bf16_t* WdnT = (bf16_t*)(a.ws + WS_WDN);
    constexpr int J0 = 32 * 192, J1 = 32 * 208, J3 = 32 * 64, J6 = 32 * 256;
    const float* W; int ldw, sc0, nblk, ldt, dr0 = 0, dk0 = 0; bf16_t* WT; int r = it;
    if (r < J0) { W = a.w_in; ldw = 12816; sc0 = 0; nblk = 192; WT = WinT; ldt = 2048; }
    else if ((r -= J0) < J1) { W = a.w_in; ldw = 12816; sc0 = 6160; nblk = 208; WT = WinT; ldt = 2048; dr0 = 6144; }
    else if ((r -= J1) < J3) { W = a.w_branch_gla; ldw = 2048; sc0 = 0; nblk = 64; WT = WabT; ldt = 4096; }
    else if ((r -= J3) < J3) { W = a.w_branch_swa; ldw = 2048; sc0 = 0; nblk = 64; WT = WabT; ldt = 4096; dk0 = 2048; }
    else if ((r -= J3) < J3) { W = a.w_out; ldw = 2048; sc0 = 0; nblk = 64; WT = WoT; ldt = 2048; }
    else if ((r -= J3) < J6) { W = a.w_ff_up; ldw = 8192; sc0 = 0; nblk = 256; WT = WupT; ldt = 2048; }
    else { r -= J6; W = a.w_ff_down; ldw = 2048; sc0 = 0; nblk = 64; WT = WdnT; ldt = 8192; }
    const int k0 = 64 * (r / nblk), n0 = 32 * (r % nblk);
    WItem w; w.src = W + (size_t)k0 * ldw + sc0 + n0; w.dst = WT + (size_t)(dr0 + n0) * ldt + dk0 + k0; w.ldw = ldw; w.ldt = ldt; return w;
}
DI void phase_weights(const Args& a, LAS unsigned char* lds, int G) {
    const int tid = tid_opaque(), lane = tid & 63, wave = tid >> 6;
    LAS float* scr = (LAS float*)(lds + wave * 8448);
    bf16_t* W16T = (bf16_t*)(a.ws + WS_W16);
    const int gw = blockIdx.x * 8 + wave, NGW = G * 8;
    constexpr int NIT = 32 * 192 + 32 * 208 + 3 * 32 * 64 + 32 * 256 + 128 * 64;
    float cur[32];
    int it = gw;
    if (it < NIT) { const WItem w = witem(a, it);
#pragma unroll
        for (int i = 0; i < 32; ++i) cur[i] = w.src[(size_t)(2 * i + (lane >> 5)) * w.ldw + (lane & 31)]; }
    for (; it < NIT; it += NGW) {
        const WItem w = witem(a, it);
#pragma unroll
        for (int i = 0; i < 32; ++i) scr[(2 * i + (lane >> 5)) * 33 + (lane & 31)] = cur[i];
        if (it + NGW < NIT) { const WItem wn = witem(a, it + NGW);
#pragma unroll
            for (int i = 0; i < 32; ++i) cur[i] = wn.src[(size_t)(2 * i + (lane >> 5)) * wn.ldw + (lane & 31)]; }
        asm volatile("s_waitcnt lgkmcnt(0)" ::: "memory");
        const int c = lane & 7;
#pragma unroll
        for (int j = 0; j < 4; ++j) { const int n = (lane >> 3) + 8 * j; const LAS float* sp = scr + (8 * c) * 33 + n;
            u32x4 o; o.x = pk2(sp[0 * 33], sp[1 * 33]); o.y = pk2(sp[2 * 33], sp[3 * 33]); o.z = pk2(sp[4 * 33], sp[5 * 33]); o.w = pk2(sp[6 * 33], sp[7 * 33]);
            *(u32x4*)(w.dst + (size_t)n * w.ldt + 8 * c) = o; }
        asm volatile("s_waitcnt lgkmcnt(0)" ::: "memory");
    }
    for (int idx = blockIdx.x * 512 + tid; idx < 32768; idx += G * 512) { const int k = idx >> 4, n = idx & 15; W16T[n * 2048 + k] = f2bf(a.w_in[(size_t)k * 12816 + 6144 + n]); }
}
DI void phase_x(const Args& a, int G) {
    const int tid = tid_opaque(), lane = tid & 63, wave = tid >> 6, fr = lane & 15, fq = lane >> 4;
    bf16_t* XB = (bf16_t*)a.out; const bf16_t* W16T = (const bf16_t*)(a.ws + WS_W16); float* GLR = (float*)(a.ws + WS_GLR);
    const int gw = blockIdx.x * 8 + wave, NGW = G * 8;
    for (int tile = gw; tile < T / 16; tile += NGW) {
        const int r0 = tile * 16;
        const float* xp = a.x + (size_t)(r0 + fr) * D + 8 * fq; bf16_t* xbp = XB + (size_t)(r0 + fr) * D + 8 * fq; const bf16_t* wp = W16T + fr * 2048 + 8 * fq;
        f32x4 acc = {0.f, 0.f, 0.f, 0.f};
        f32x4 xa[8], xb[8]; bf16x8 wa[4], wb[4];
#define X_LOAD(XV, WV, kb) do { _Pragma("unroll") for (int i = 0; i < 4; ++i) { const int ks = 4 * (kb) + i; XV[2 * i] = *(const f32x4*)(xp + 32 * ks); XV[2 * i + 1] = *(const f32x4*)(xp + 32 * ks + 4); WV[i] = *(const bf16x8*)(wp + 32 * ks); } } while (0)
#define X_PROC(XV, WV, kb) do { _Pragma("unroll") for (int i = 0; i < 4; ++i) { const int ks = 4 * (kb) + i; const f32x4 v0 = XV[2 * i], v1 = XV[2 * i + 1]; \
            u32x4 p; p.x = pk2(v0[0], v0[1]); p.y = pk2(v0[2], v0[3]); p.z = pk2(v1[0], v1[1]); p.w = pk2(v1[2], v1[3]); \
            *(u32x4*)(xbp + 32 * ks) = p; acc = MFMA16(__builtin_bit_cast(bf16x8, p), WV[i], acc); } } while (0)
        X_LOAD(xa, wa, 0);
#pragma unroll 1
        for (int kb = 0; kb < 16; kb += 2) {
            X_LOAD(xb, wb, kb + 1);
            X_PROC(xa, wa, kb);
            if (kb + 2 < 16) X_LOAD(xa, wa, kb + 2);
            X_PROC(xb, wb, kb + 1);
        }
#undef X_LOAD
#undef X_PROC
#pragma unroll
        for (int i = 0; i < 4; ++i) GLR[(size_t)(r0 + 4 * fq + i) * 16 + fr] = acc[i];
    }
}
DI float log_sigmoid_f(float z) { return fminf(z, 0.f) - __logf(1.f + __expf(-fabsf(z))); }
DI void phase_gla_prep(const Args& a, LAS unsigned char* lds, int G, bool dry) {
    const int tid = tid_opaque(), lane = tid & 63, wave = tid >> 6, d = tid & 255, sh = tid >> 8, r = lane & 31, hh = lane >> 5;
    bf16_t* P = (bf16_t*)(a.ws + WS_PROJ); const float* GLR = (const float*)(a.ws + WS_GLR); bf16_t* SC = (bf16_t*)(a.ws + WS_SC); float* DEC = (float*)(a.ws + WS_DEC);
    LAS float* glr_s = (LAS float*)lds; LAS float* tot = (LAS float*)(lds + 4096);
    LAS bf16_t* QI = (LAS bf16_t*)(lds + 8192); LAS bf16_t* KI = (LAS bf16_t*)(lds + 8192 + 33792); LAS bf16_t* KT = (LAS bf16_t*)(lds + 8192 + 2 * 33792);
    for (int u = blockIdx.x; u < 2048; u += G) {
        const int b = u >> 10, n = (u & 1023) >> 2, h = u & 3, t0 = b * SEQ + n * 64;
        if (tid < 256) ((LAS f32x4*)glr_s)[tid] = ((const f32x4*)(GLR + (size_t)t0 * 16))[tid];
#pragma unroll
        for (int i = 0; i < 4; ++i) { const int c = tid + 512 * i, row = c >> 5, c16 = c & 31; const bf16_t* src = P + (size_t)(t0 + row) * NP + h * 256 + c16 * 8;
            *(LAS u32x4*)(QI + row * 264 + c16 * 8) = *(const u32x4*)(src + C_GQ); *(LAS u32x4*)(KI + row * 264 + c16 * 8) = *(const u32x4*)(src + C_GK); }
        float wu[16];
#pragma unroll
        for (int j = 0; j < 16; ++j) wu[j] = a.w_alpha_up[j * 1024 + h * 256 + d];
        const float ba = a.b_alpha[h * 256 + d];
        __syncthreads();
        float cs[32];
        { float cum = 0.f;
#pragma unroll
          for (int s = 0; s < 32; ++s) { const LAS float* gp = glr_s + (sh * 32 + s) * 16; float z = ba;
#pragma unroll
              for (int j = 0; j < 16; ++j) z += gp[j] * wu[j];
              cum += log_sigmoid_f(z) * 0.0625f; cs[s] = cum; }
          tot[sh * 256 + d] = cum; }
        __syncthreads();
        const float t0v = tot[d], t1v = tot[256 + d], blast = t0v + t1v, coff = sh ? t0v : 0.f;
        LAS unsigned* kt32 = (LAS unsigned*)KT;
#pragma unroll
        for (int s2 = 0; s2 < 16; ++s2) { float kd[2];
#pragma unroll
            for (int e = 0; e < 2; ++e) { const int s = sh * 32 + 2 * s2 + e; const float cum = cs[2 * s2 + e] + coff;
                const float q = bf2f(QI[s * 264 + d]), k = bf2f(KI[s * 264 + d]);
                QI[s * 264 + d] = f2bf(q * 0.0625f * __expf(cum)); KI[s * 264 + d] = f2bf(k * __expf(-cum)); kd[e] = k * __expf(blast - cum); }
            kt32[d * 36 + sh * 16 + s2] = pk2(kd[0], kd[1]); }
        __syncthreads();
        if (wave < 4) { const int mt = wave >> 1, nt = wave & 1; f32x16 acc;
#pragma unroll
            for (int i = 0; i < 16; ++i) acc[i] = 0.f;
#pragma unroll 4
            for (int ks = 0; ks < 16; ++ks) { const bf16x8 av = *(const LAS bf16x8*)(QI + (32 * mt + r) * 264 + 16 * ks + 8 * hh), bv = *(const LAS bf16x8*)(KI + (32 * nt + r) * 264 + 16 * ks + 8 * hh);
                acc = MFMA32(av, bv, acc); }
            bf16_t* scp = redir(SC + (size_t)u * 4096, dry, a.ws);
#pragma unroll
            for (int i = 0; i < 16; ++i) { const int sq = 32 * mt + crow(i, hh), sk = 32 * nt + r; scp[sq * 64 + sk] = f2bf(sk <= sq ? acc[i] : 0.f); } }
#pragma unroll
        for (int i = 0; i < 4; ++i) { const int c = tid + 512 * i, row = c >> 5, c16 = c & 31;
            *(u32x4*)redir(P + (size_t)(t0 + row) * NP + C_GQ + h * 256 + c16 * 8, dry, a.ws) = *(const LAS u32x4*)(QI + row * 264 + c16 * 8); }
        { bf16_t* dst = redir(P + (size_t)(t0 + (d >> 2)) * NP + C_GK + h * 256 + (d & 3) * 64 + sh * 32, dry, a.ws);
#pragma unroll
          for (int i = 0; i < 4; ++i) *(u32x4*)(dst + 8 * i) = *(const LAS u32x4*)(KT + d * 72 + sh * 32 + 8 * i); }
        if (sh == 0) *redir(DEC + (size_t)u * 256 + d, dry, a.ws) = expf(blast);
        __syncthreads();
    }
}
DI bf16x8 pack8(const f32x16& x, int s) {
    u32x4 p; p.x = pk2(x[8 * s], x[8 * s + 1]); p.y = pk2(x[8 * s + 2], x[8 * s + 3]); p.z = pk2(x[8 * s + 4], x[8 * s + 5]); p.w = pk2(x[8 * s + 6], x[8 * s + 7]);
    return __builtin_bit_cast(bf16x8, p);
}
DI bf16x8 ld2x8(const LAS bf16_t* p) { const u32x2 lo = *(const LAS u32x2*)p, hi = *(const LAS u32x2*)(p + 8); u32x4 v; v.x = lo.x; v.y = lo.y; v.z = hi.x; v.w = hi.y; return __builtin_bit_cast(bf16x8, v); }
DI unsigned bfsel(const u32x4& v, int j) { const unsigned w = v[j >> 1]; return (j & 1) ? (w >> 16) : (w & 0xffffu); }
template <bool FULL, bool NOLOAD = false>
DI void phase_gla_scan(const Args& a, LAS unsigned char* lds, int stream, int seg, bool dry) {
    const int tid = tid_opaque(), lane = tid & 63, wave = tid >> 6, r = lane & 31, hh = lane >> 5, wm = wave >> 1, wn = wave & 1;
    const int bh = stream >> 3, b = bh >> 2, h = bh & 3, sl = stream & 7, dv0 = sl * 64, nbeg = seg * 64;
    bf16_t* P = (bf16_t*)(a.ws + WS_PROJ); const bf16_t* SC = (const bf16_t*)(a.ws + WS_SC); const float* DEC = (const float*)(a.ws + WS_DEC); float* SSQ = (float*)(a.ws + WS_SSQ);
    float* LG = (float*)(a.ws + WS_LG); float* DG = (float*)(a.ws + WS_DG);
    LAS bf16_t* QIs = (LAS bf16_t*)lds; LAS bf16_t* KDs = (LAS bf16_t*)(lds + 33792); LAS bf16_t* VTs = (LAS bf16_t*)(lds + 70656);
    LAS bf16_t* SCs = (LAS bf16_t*)(lds + 79872); LAS float* DECs = (LAS float*)(lds + 89088); LAS float* PART = (LAS float*)lds;
    f32x16 S0, S1;
#pragma unroll
    for (int i = 0; i < 16; ++i) { S0[i] = 0.f; S1[i] = 0.f; }
    if (FULL) {
        for (int gg = 0; gg < seg; ++gg) { const float* lp = LG + ((size_t)(stream * 4 + gg) * 512 + tid) * 32; const float* dp = DG + (size_t)(stream * 4 + gg) * 256 + 64 * wm;
#pragma unroll
            for (int i4 = 0; i4 < 4; ++i4) { const f32x4 l0 = *(const f32x4*)(lp + 4 * i4), l1 = *(const f32x4*)(lp + 16 + 4 * i4);
#pragma unroll
                for (int e = 0; e < 4; ++e) { const int i = 4 * i4 + e; S0[i] = S0[i] * dp[crow(i, hh)] + l0[e]; S1[i] = S1[i] * dp[32 + crow(i, hh)] + l1[e]; } } }
    }
    float dprod = 1.f;
    u32x4 pq[4], pk[4], pva, pvb, psc, pdec;
    const int ldrow = tid >> 5, ldc16 = tid & 31, vp = tid & 31, vg8 = (tid >> 5) & 7, scrow = tid >> 3, scc8 = tid & 7;
#define SCAN_LOAD(nn) do { const int t0_ = b * SEQ + (nn) * 64, u_ = b * 1024 + (nn) * 4 + h; \
        _Pragma("unroll") for (int i = 0; i < 4; ++i) { const bf16_t* src = P + (size_t)(t0_ + ldrow + 16 * i) * NP + h * 256 + ldc16 * 8; if (FULL) pq[i] = *(const u32x4*)(src + C_GQ); pk[i] = *(const u32x4*)(src + C_GK); } \
        { const bf16_t* src = P + (size_t)(t0_ + 2 * vp) * NP + C_GV + h * 512 + dv0 + vg8 * 8; pva = *(const u32x4*)src; pvb = *(const u32x4*)(src + NP); } \
        if (FULL) psc = *(const u32x4*)(SC + (size_t)u_ * 4096 + scrow * 64 + scc8 * 8); \
        pdec = ((const u32x4*)(DEC + (size_t)u_ * 256))[tid & 63]; } while (0)
    SCAN_LOAD(nbeg);
#pragma unroll 1
    for (int n = nbeg; n < nbeg + 64; ++n) {
        const int t0 = b * SEQ + n * 64;
        LBAR();
#pragma unroll
        for (int i = 0; i < 4; ++i) { const int row = ldrow + 16 * i;
            if (FULL) *(LAS u32x4*)(QIs + row * 264 + ldc16 * 8) = pq[i];
            *(LAS u32x4*)(KDs + (4 * row + (ldc16 >> 3)) * 72 + (ldc16 & 7) * 8) = pk[i]; }
        if (tid < 256) { LAS unsigned* vt32 = (LAS unsigned*)VTs;
#pragma unroll
            for (int j = 0; j < 8; ++j) vt32[(vg8 * 8 + j) * 36 + vp] = bfsel(pva, j) | (bfsel(pvb, j) << 16); }
        if (FULL) *(LAS u32x4*)(SCs + scrow * 72 + scc8 * 8) = psc;
        if (tid < 64) ((LAS u32x4*)DECs)[tid] = pdec;
        if (!FULL && !NOLOAD) { if (n + 1 < nbeg + 64) SCAN_LOAD(n + 1); }
        LBAR();
        f32x16 o0, o1;
        const int nn_ = (n + 1 < nbeg + 64) ? n + 1 : n;
        const bf16_t* qk_n = P + (size_t)(b * SEQ + nn_ * 64 + ldrow) * NP + h * 256 + ldc16 * 8;
        const bf16_t* v_n = P + (size_t)(b * SEQ + nn_ * 64 + 2 * vp) * NP + C_GV + h * 512 + dv0 + vg8 * 8;
        const size_t u_n = (size_t)(b * 1024 + nn_ * 4 + h);
#define ILOAD(stmt) do { if (FULL && !NOLOAD) { __builtin_amdgcn_sched_barrier(0); stmt; __builtin_amdgcn_sched_barrier(0); } } while (0)
        if (FULL) {
#pragma unroll
            for (int i = 0; i < 16; ++i) { o0[i] = 0.f; o1[i] = 0.f; }
#pragma unroll
            for (int tl = 0; tl < 2; ++tl)
#pragma unroll
                for (int s2 = 0; s2 < 2; ++s2) { const bf16x8 bfrag = pack8(tl ? S1 : S0, s2); const int dkb = 64 * wm + 32 * tl + 16 * s2 + 4 * hh;
                    o0 = MFMA32(ld2x8(QIs + r * 264 + dkb), bfrag, o0); o1 = MFMA32(ld2x8(QIs + (32 + r) * 264 + dkb), bfrag, o1);
                    ILOAD(pq[2 * tl + s2] = *(const u32x4*)(qk_n + (size_t)(16 * (2 * tl + s2)) * NP + C_GQ); pk[2 * tl + s2] = *(const u32x4*)(qk_n + (size_t)(16 * (2 * tl + s2)) * NP + C_GK)); }
            { const bf16x8 bv = *(const LAS bf16x8*)(VTs + (32 * wn + r) * 72 + 16 * wm + 8 * hh);
              o0 = MFMA32(*(const LAS bf16x8*)(SCs + r * 72 + 16 * wm + 8 * hh), bv, o0); o1 = MFMA32(*(const LAS bf16x8*)(SCs + (32 + r) * 72 + 16 * wm + 8 * hh), bv, o1); }
            ILOAD(pva = *(const u32x4*)v_n);
        } else { if (tid < 256) dprod *= DECs[tid]; }
#pragma unroll
        for (int i = 0; i < 16; ++i) { S0[i] *= DECs[64 * wm + crow(i, hh)]; S1[i] *= DECs[64 * wm + 32 + crow(i, hh)]; }
#pragma unroll
        for (int ks = 0; ks < 4; ++ks) { const bf16x8 bv = *(const LAS bf16x8*)(VTs + (32 * wn + r) * 72 + 16 * ks + 8 * hh);
            S0 = MFMA32(*(const LAS bf16x8*)(KDs + (64 * wm + r) * 72 + 16 * ks + 8 * hh), bv, S0);
            S1 = MFMA32(*(const LAS bf16x8*)(KDs + (64 * wm + 32 + r) * 72 + 16 * ks + 8 * hh), bv, S1);
            if (ks == 0) ILOAD(pvb = *(const u32x4*)(v_n + NP));
            if (ks == 1) ILOAD(psc = *(const u32x4*)(SC + u_n * 4096 + scrow * 64 + scc8 * 8));
            if (ks == 2) ILOAD(pdec = ((const u32x4*)(DEC + u_n * 256))[tid & 63]); }
#undef ILOAD
        if (FULL) {
            LBAR();
#pragma unroll
            for (int i = 0; i < 16; ++i) { PART[(wm * 64 + crow(i, hh)) * 68 + 32 * wn + r] = o0[i]; PART[(wm * 64 + 32 + crow(i, hh)) * 68 + 32 * wn + r] = o1[i]; }
            LBAR();
            { const int s = tid >> 3, c8 = tid & 7; f32x4 a0 = {0.f, 0.f, 0.f, 0.f}, a1 = a0;
#pragma unroll
              for (int w4 = 0; w4 < 4; ++w4) { const LAS float* pp = PART + (w4 * 64 + s) * 68 + c8 * 8; a0 += *(const LAS f32x4*)pp; a1 += *(const LAS f32x4*)(pp + 4); }
              float ssq = a0[0] * a0[0] + a0[1] * a0[1] + a0[2] * a0[2] + a0[3] * a0[3] + a1[0] * a1[0] + a1[1] * a1[1] + a1[2] * a1[2] + a1[3] * a1[3];
              ssq += __shfl_xor(ssq, 1); ssq += __shfl_xor(ssq, 2); ssq += __shfl_xor(ssq, 4);
              if (c8 == 0) *redir(SSQ + (size_t)(t0 + s) * 32 + h * 8 + sl, dry, a.ws) = ssq;
              u32x4 w; w.x = pk2(a0[0], a0[1]); w.y = pk2(a0[2], a0[3]); w.z = pk2(a1[0], a1[1]); w.w = pk2(a1[2], a1[3]);
              *(u32x4*)redir(P + (size_t)(t0 + s) * NP + C_GV + h * 512 + dv0 + c8 * 8, dry, a.ws) = w; }
        }
    }
#undef SCAN_LOAD
    if (!FULL) {
        float* lp = LG + ((size_t)(stream * 4 + seg) * 512 + tid) * 32;
#pragma unroll
        for (int i4 = 0; i4 < 4; ++i4) { *(f32x4*)(lp + 4 * i4) = (f32x4){S0[4 * i4], S0[4 * i4 + 1], S0[4 * i4 + 2], S0[4 * i4 + 3]}; *(f32x4*)(lp + 16 + 4 * i4) = (f32x4){S1[4 * i4], S1[4 * i4 + 1], S1[4 * i4 + 2], S1[4 * i4 + 3]}; }
        if (tid < 256) DG[(size_t)(stream * 4 + seg) * 256 + tid] = dprod;
    }
}
DI void phase_gla_scan_p1(const Args& a, LAS unsigned char* lds, int stream, int seg) {
    const int tid = tid_opaque(), lane = tid & 63, wave = tid >> 6, r = lane & 31, hh = lane >> 5, wm = wave >> 1, wn = wave & 1;
    const int bh = stream >> 3, b = bh >> 2, h = bh & 3, sl = stream & 7, dv0 = sl * 64, nbeg = seg * 64;
    const bf16_t* P = (const bf16_t*)(a.ws + WS_PROJ); const float* DEC = (const float*)(a.ws + WS_DEC);
    float* LG = (float*)(a.ws + WS_LG); float* DG = (float*)(a.ws + WS_DG);
    LAS bf16_t* KDs = (LAS bf16_t*)(lds + 33792); LAS bf16_t* VTs = (LAS bf16_t*)(lds + 70656); LAS float* DECs = (LAS float*)(lds + 89088);
    f32x16 S0, S1;
#pragma unroll
    for (int i = 0; i < 16; ++i) { S0[i] = 0.f; S1[i] = 0.f; }
    float dprod = 1.f;
    const int ldrow = tid >> 5, ldc16 = tid & 31, vp = tid & 31, vg8 = (tid >> 5) & 7;
    const bf16_t* kbase = P + (size_t)(b * SEQ + ldrow) * NP + C_GK + h * 256 + ldc16 * 8;
    const bf16_t* vbase = P + (size_t)(b * SEQ + 2 * vp) * NP + C_GV + h * 512 + dv0 + vg8 * 8;
    const float* dbase = DEC + (size_t)(b * 1024 + h) * 256 + (tid & 63) * 4;
    u32x4 ak[4], ava, avb, adec, bk[4], bva, bvb, bdec;
#define P1_LOAD(K_, VA_, VB_, D_, nn) do { const size_t ro_ = (size_t)(nn) * 64 * NP; \
        _Pragma("unroll") for (int i = 0; i < 4; ++i) K_[i] = *(const u32x4*)(kbase + ro_ + (size_t)(16 * i) * NP); \
        VA_ = *(const u32x4*)(vbase + ro_); VB_ = *(const u32x4*)(vbase + ro_ + NP); D_ = *(const u32x4*)(dbase + (size_t)(nn) * 1024); } while (0)
#define P1_STEP(K_, VA_, VB_, D_, nnext) do { \
        LBAR(); \
        _Pragma("unroll") for (int i = 0; i < 4; ++i) { const int row = ldrow + 16 * i; *(LAS u32x4*)(KDs + (4 * row + (ldc16 >> 3)) * 72 + (ldc16 & 7) * 8) = K_[i]; } \
        if (tid < 256) { LAS unsigned* vt32 = (LAS unsigned*)VTs; _Pragma("unroll") for (int j = 0; j < 8; ++j) vt32[(vg8 * 8 + j) * 36 + vp] = bfsel(VA_, j) | (bfsel(VB_, j) << 16); } \
        if (tid < 64) ((LAS u32x4*)DECs)[tid] = D_; \
        if ((nnext) < nbeg + 64) P1_LOAD(K_, VA_, VB_, D_, (nnext)); \
        LBAR(); \
        if (tid < 256) dprod *= DECs[tid]; \
        _Pragma("unroll") for (int i = 0; i < 16; ++i) { S0[i] *= DECs[64 * wm + crow(i, hh)]; S1[i] *= DECs[64 * wm + 32 + crow(i, hh)]; } \
        _Pragma("unroll") for (int ks = 0; ks < 4; ++ks) { const bf16x8 bv = *(const LAS bf16x8*)(VTs + (32 * wn + r) * 72 + 16 * ks + 8 * hh); \
            S0 = MFMA32(*(const LAS bf16x8*)(KDs + (64 * wm + r) * 72 + 16 * ks + 8 * hh), bv, S0); \
            S1 = MFMA32(*(const LAS bf16x8*)(KDs + (64 * wm + 32 + r) * 72 + 16 * ks + 8 * hh), bv, S1); } } while (0)
    P1_LOAD(ak, ava, avb, adec, nbeg); P1_LOAD(bk, bva, bvb, bdec, nbeg + 1);
#pragma unroll 1
    for (int n = nbeg; n < nbeg + 64; n += 2) { P1_STEP(ak, ava, avb, adec, n + 2); P1_STEP(bk, bva, bvb, bdec, n + 3); }
#undef P1_LOAD
#undef P1_STEP
    float* lp = LG + ((size_t)(stream * 4 + seg) * 512 + tid) * 32;
#pragma unroll
    for (int i4 = 0; i4 < 4; ++i4) { *(f32x4*)(lp + 4 * i4) = (f32x4){S0[4 * i4], S0[4 * i4 + 1], S0[4 * i4 + 2], S0[4 * i4 + 3]}; *(f32x4*)(lp + 16 + 4 * i4) = (f32x4){S1[4 * i4], S1[4 * i4 + 1], S1[4 * i4 + 2], S1[4 * i4 + 3]}; }
    if (tid < 256) DG[(size_t)(stream * 4 + seg) * 256 + tid] = dprod;
}
DI void phase_swa(const Args& a, LAS unsigned char* lds, int ubeg, int ustep, int uend, bool dry) {
    const int tid = tid_opaque(), lane = tid & 63, wave = tid >> 6, r = lane & 31, hh = lane >> 5;
    bf16_t* P = (bf16_t*)(a.ws + WS_PROJ);
    LAS bf16_t* Ks = (LAS bf16_t*)lds; LAS bf16_t* VT = (LAS bf16_t*)(lds + 36864); LAS unsigned* VT32 = (LAS unsigned*)(lds + 36864);
    for (int u = ubeg; u < uend; u += ustep) {
        const int b = u >> 9, nb = (u & 511) >> 2, kh = u & 3, tq0 = b * SEQ + 128 * nb, tk0 = tq0 - 128;
        __syncthreads();
#pragma unroll
        for (int i = 0; i < 4; ++i) { const int c = tid + 512 * i, key = c >> 3, c8 = c & 7; u32x4 v = {0u, 0u, 0u, 0u};
            if (nb > 0 || key >= 128) v = *(const u32x4*)(P + (size_t)(tk0 + key) * NP + C_SK + kh * 64 + c8 * 8);
            *(LAS u32x4*)(Ks + key * 72 + c8 * 8) = v; }
#pragma unroll
        for (int i = 0; i < 2; ++i) { const int task = tid + 512 * i, p = task & 127, g8 = task >> 7; u32x4 va = {0u, 0u, 0u, 0u}, vb = va;
            if (nb > 0 || p >= 64) { const bf16_t* src = P + (size_t)(tk0 + 2 * p) * NP + C_SV + kh * 64 + g8 * 8; va = *(const u32x4*)src; vb = *(const u32x4*)(src + NP); }
#pragma unroll
            for (int j = 0; j < 8; ++j) VT32[(g8 * 8 + j) * 130 + p] = bfsel(va, j) | (bfsel(vb, j) << 16); }
        __syncthreads();
        const int hq = kh * 8 + wave; const float slope = exp2f(-0.25f * (float)(hq + 1)), sink = a.attn_sinks[hq];
        const float sl2 = slope * 1.4426950408889634f, c0l2 = 0.125f * 1.4426950408889634f, sink2 = sink * 1.4426950408889634f;
        bf16x8 bq[4];
        { const bf16_t* q0 = P + (size_t)(tq0 + r) * NP + C_SQ + hq * 64;
#pragma unroll
          for (int ks = 0; ks < 4; ++ks) bq[ks] = *(const bf16x8*)(q0 + 16 * ks + 8 * hh); }
#pragma unroll 1
        for (int j = 0; j < 4; ++j) {
            const size_t tq = (size_t)(tq0 + 32 * j + r);
            bf16_t* qrow = P + tq * NP + C_SQ + hq * 64;
            f32x16 st[5];
#pragma unroll
            for (int kt = 0; kt < 5; ++kt) { f32x16 acc;
#pragma unroll
                for (int i = 0; i < 16; ++i) acc[i] = 0.f;
#pragma unroll
                for (int ks = 0; ks < 4; ++ks) acc = MFMA32(*(const LAS bf16x8*)(Ks + (32 * (j + kt) + r) * 72 + 16 * ks + 8 * hh), bq[ks], acc);
                st[kt] = acc; }
            if (j < 3) { const bf16_t* qn = qrow + (size_t)32 * NP;
#pragma unroll
                for (int ks = 0; ks < 4; ++ks) bq[ks] = *(const bf16x8*)(qn + 16 * ks + 8 * hh); }
            float l;
            int b2 = r + 128 - 4 * hh; asm volatile("" : "+v"(b2));
            if (nb > 0) {
                const float sb = sl2 * (float)b2; float m = sink2;
#pragma unroll
                for (int kt = 0; kt < 5; ++kt)
#pragma unroll
                    for (int i = 0; i < 16; ++i) { const int cc = 32 * kt + (i & 3) + 8 * (i >> 2); float lg = fmaf(st[kt][i], c0l2, fmaf(sl2, (float)cc, -sb));
                        if (kt == 0) lg = (b2 - cc < 128) ? lg : -1e30f;
                        if (kt == 4) lg = (b2 - cc >= 0) ? lg : -1e30f;
                        st[kt][i] = lg; m = fmaxf(m, lg); }
                m = fmaxf(m, __shfl_xor(m, 32));
                l = 0.f;
#pragma unroll
                for (int kt = 0; kt < 5; ++kt)
#pragma unroll
                    for (int i = 0; i < 16; ++i) { const float p = __builtin_amdgcn_exp2f(st[kt][i] - m); st[kt][i] = p; l += p; }
                l += __shfl_xor(l, 32); l += __builtin_amdgcn_exp2f(sink2 - m);
            } else {
                float m = sink;
                const int minkf2 = (128 - 32 * j) - 4 * hh;
#pragma unroll
                for (int kt = 0; kt < 5; ++kt)
#pragma unroll
                    for (int i = 0; i < 16; ++i) { const int cc = 32 * kt + (i & 3) + 8 * (i >> 2), dist = b2 - cc; const bool valid = ((unsigned)dist < 128u) && (cc >= minkf2);
                        const float lg = valid ? st[kt][i] * 0.125f - slope * (float)dist : -1e30f; st[kt][i] = lg; m = fmaxf(m, lg); }
                m = fmaxf(m, __shfl_xor(m, 32));
                l = 0.f;
#pragma unroll
                for (int kt = 0; kt < 5; ++kt)
#pragma unroll
                    for (int i = 0; i < 16; ++i) { const float p = __expf(st[kt][i] - m); st[kt][i] = p; l += p; }
                l += __shfl_xor(l, 32); l += __expf(sink - m);
            }
            const float inv = 1.f / l;
            f32x16 oa, ob;
#pragma unroll
            for (int i = 0; i < 16; ++i) { oa[i] = 0.f; ob[i] = 0.f; }
#pragma unroll
            for (int kt = 0; kt < 5; ++kt)
#pragma unroll
                for (int s2 = 0; s2 < 2; ++s2) { const bf16x8 bfrag = pack8(st[kt], s2); const int keyb = 32 * (j + kt) + 16 * s2 + 4 * hh;
                    oa = MFMA32(ld2x8(VT + r * 260 + keyb), bfrag, oa); ob = MFMA32(ld2x8(VT + (32 + r) * 260 + keyb), bfrag, ob); }
#pragma unroll
            for (int i4 = 0; i4 < 4; ++i4) { const int d0 = 8 * i4 + 4 * hh; u32x2 w0, w1;
                w0.x = pk2(oa[4 * i4] * inv, oa[4 * i4 + 1] * inv); w0.y = pk2(oa[4 * i4 + 2] * inv, oa[4 * i4 + 3] * inv);
                w1.x = pk2(ob[4 * i4] * inv, ob[4 * i4 + 1] * inv); w1.y = pk2(ob[4 * i4 + 2] * inv, ob[4 * i4 + 3] * inv);
                *(u32x2*)redir(qrow + d0, dry, a.ws) = w0; *(u32x2*)redir(qrow + 32 + d0, dry, a.ws) = w1; }
        }
    }
}
DI void phase_gla_norm(const Args& a, int G, bool dry) {
    const int tid = tid_opaque(), lane = tid & 63, wave = tid >> 6;
    bf16_t* P = (bf16_t*)(a.ws + WS_PROJ); const float* SSQ = (const float*)(a.ws + WS_SSQ);
    const f32x4 w0 = *(const f32x4*)(a.gla_norm_w + lane * 8), w1 = *(const f32x4*)(a.gla_norm_w + lane * 8 + 4);
    const float wv[8] = {w0[0], w0[1], w0[2], w0[3], w1[0], w1[1], w1[2], w1[3]};
    u32x4 o8[4], g8[4]; f32x4 sq[8];
#define NORM_LOAD(tt) do { const bf16_t* rp_ = P + (size_t)(tt) * NP + lane * 8; \
        _Pragma("unroll") for (int j = 0; j < 4; ++j) { o8[j] = *(const u32x4*)(rp_ + C_GV + j * 512); g8[j] = *(const u32x4*)(rp_ + C_GO + j * 512); \
            sq[2 * j] = *(const f32x4*)(SSQ + (size_t)(tt) * 32 + j * 8); sq[2 * j + 1] = *(const f32x4*)(SSQ + (size_t)(tt) * 32 + j * 8 + 4); } } while (0)
    int t = blockIdx.x * 8 + wave;
    if (t < T) NORM_LOAD(t);
    for (; t < T; t += G * 8) {
        bf16_t* rowp = P + (size_t)t * NP;
        u32x4 wout[4];
#pragma unroll
        for (int j = 0; j < 4; ++j) { const f32x4 s0 = sq[2 * j], s1 = sq[2 * j + 1];
            const float ss = (s0[0] + s0[1]) + (s0[2] + s0[3]) + (s1[0] + s1[1]) + (s1[2] + s1[3]); const float rstd = rsqrtf(ss * (1.f / 512.f) + 1e-6f);
#pragma unroll
            for (int q = 0; q < 4; ++q) { const float ga = bflo(g8[j][q]), gb = bfhi(g8[j][q]);
                const float ra = bflo(o8[j][q]) * rstd * wv[2 * q] * (ga / (1.f + __expf(-ga))), rb = bfhi(o8[j][q]) * rstd * wv[2 * q + 1] * (gb / (1.f + __expf(-gb)));
                wout[j][q] = pk2(ra, rb); } }
        if (t + G * 8 < T) NORM_LOAD(t + G * 8);
#pragma unroll
        for (int j = 0; j < 4; ++j) *(u32x4*)redir(rowp + C_GO + j * 512 + lane * 8, dry, a.ws) = wout[j];
    }
#undef NORM_LOAD
}
template <bool BF, bool F32OUT>
DI void phase_ln(const float* in, int ldi, float* out, int ldo, bf16_t* ob, int ldb, const float* gam, const float* bet, int G, bool dry, unsigned char* ws) {
    const int tid = tid_opaque(), lane = tid & 63, wave = tid >> 6;
    for (int t = blockIdx.x * 8 + wave; t < T; t += G * 8) {
        const float* ip = in + (size_t)t * ldi + lane * 4; f32x4 v[8]; float s = 0.f;
#pragma unroll
        for (int j = 0; j < 8; ++j) { v[j] = *(const f32x4*)(ip + j * 256); s += (v[j][0] + v[j][1]) + (v[j][2] + v[j][3]); }
#pragma unroll
        for (int o = 1; o < 64; o <<= 1) s += __shfl_xor(s, o);
        const float mean = s * (1.f / 2048.f); float q = 0.f;
#pragma unroll
        for (int j = 0; j < 8; ++j) { v[j] = v[j] - mean; q += (v[j][0] * v[j][0] + v[j][1] * v[j][1]) + (v[j][2] * v[j][2] + v[j][3] * v[j][3]); }
#pragma unroll
        for (int o = 1; o < 64; o <<= 1) q += __shfl_xor(q, o);
        const float rstd = rsqrtf(q * (1.f / 2048.f) + 1e-5f);
        float* op = out + (size_t)t * ldo + lane * 4;
#pragma unroll
        for (int j = 0; j < 8; ++j) { const f32x4 gv = *(const f32x4*)(gam + j * 256 + lane * 4), bv = *(const f32x4*)(bet + j * 256 + lane * 4); const f32x4 y = v[j] * rstd * gv + bv;
            if (F32OUT) *(f32x4*)redir(op + j * 256, dry, ws) = y;
            if (BF) { u32x2 w; w.x = pk2(y[0], y[1]); w.y = pk2(y[2], y[3]); *(u32x2*)redir(ob + (size_t)t * ldb + j * 256 + lane * 4, dry, ws) = w; } }
    }
}


template <bool F32OUT>
DI void phase_ln_bf(const bf16_t* in, int ldi, float* outf, int ldo, bf16_t* ob, int ldb, const float* gam, const float* bet, int G, bool dry, unsigned char* ws) {
    const int tid = tid_opaque(), lane = tid & 63, wave = tid >> 6;
    u32x4 nx[4];
    int t = blockIdx.x * 8 + wave;
    if (t < T) {
#pragma unroll
        for (int j = 0; j < 4; ++j) nx[j] = *(const u32x4*)(in + (size_t)t * ldi + lane * 8 + j * 512); }
    for (; t < T; t += G * 8) {
        f32x4 v[8]; float s = 0.f;
#pragma unroll
        for (int j = 0; j < 4; ++j) { const u32x4 w = nx[j]; v[2 * j] = (f32x4){bflo(w.x), bfhi(w.x), bflo(w.y), bfhi(w.y)}; v[2 * j + 1] = (f32x4){bflo(w.z), bfhi(w.z), bflo(w.w), bfhi(w.w)};
            s += ((v[2 * j][0] + v[2 * j][1]) + (v[2 * j][2] + v[2 * j][3])) + ((v[2 * j + 1][0] + v[2 * j + 1][1]) + (v[2 * j + 1][2] + v[2 * j + 1][3])); }
        if (t + G * 8 < T) {
#pragma unroll
            for (int j = 0; j < 4; ++j) nx[j] = *(const u32x4*)(in + (size_t)(t + G * 8) * ldi + lane * 8 + j * 512); }
#pragma unroll
        for (int o = 1; o < 64; o <<= 1) s += __shfl_xor(s, o);
        const float mean = s * (1.f / 2048.f); float q = 0.f;
#pragma unroll
        for (int j = 0; j < 8; ++j) { v[j] = v[j] - mean; q += (v[j][0] * v[j][0] + v[j][1] * v[j][1]) + (v[j][2] * v[j][2] + v[j][3] * v[j][3]); }
#pragma unroll
        for (int o = 1; o < 64; o <<= 1) q += __shfl_xor(q, o);
        const float rstd = rsqrtf(q * (1.f / 2048.f) + 1e-5f);
#pragma unroll
        for (int j = 0; j < 4; ++j) { const int col = j * 512 + lane * 8;
            const f32x4 g0 = *(const f32x4*)(gam + col), g1 = *(const f32x4*)(gam + col + 4), b0 = *(const f32x4*)(bet + col), b1 = *(const f32x4*)(bet + col + 4);
            const f32x4 y0 = v[2 * j] * rstd * g0 + b0, y1 = v[2 * j + 1] * rstd * g1 + b1;
            if (F32OUT) { float* op = outf + (size_t)t * ldo + col; *(f32x4*)redir(op, dry, ws) = y0; *(f32x4*)redir(op + 4, dry, ws) = y1; }
            else { u32x4 w; w.x = pk2(y0[0], y0[1]); w.y = pk2(y0[2], y0[3]); w.z = pk2(y1[0], y1[1]); w.w = pk2(y1[2], y1[3]); *(u32x4*)redir(ob + (size_t)t * ldb + col, dry, ws) = w; } }
    }
}

#define XB_TMO      128
#define XB_XCNT(j)  (256  + 64 * (j))
#define XB_XSUB(j)  (1280 + 64 * (j))
#define XB_XGEN(j)  (2304 + 64 * (j))
#define XB_TOP      3328
#define XB_TOPGEN   3392
#define XCD_BAR_WORDS 3456
#define XB_SPIN_CAP (1u << 18)
DI unsigned xb_ld(unsigned* p)              { return __hip_atomic_load(p, __ATOMIC_RELAXED, __HIP_MEMORY_SCOPE_AGENT); }
DI unsigned xb_add(unsigned* p, unsigned v) { return __hip_atomic_fetch_add(p, v, __ATOMIC_RELAXED, __HIP_MEMORY_SCOPE_AGENT); }
DI unsigned xb_xcc_id() { return (unsigned)__builtin_amdgcn_s_getreg((3 << 11) | 20) & 0xFu; }
#define XB_SPIN(cond, bar) do { unsigned _sp = 0; while (cond) { __builtin_amdgcn_s_sleep(1); \
    if ((++_sp & 255u) == 0u) { if (xb_ld(&(bar)[XB_TMO])) break; if (_sp > XB_SPIN_CAP) { atomicAdd(&(bar)[XB_TMO], 1u); break; } } } } while (0)
struct XcdBarrier { unsigned* bar; unsigned x; volatile LAS unsigned* st; };
DI XcdBarrier xcd_barrier_post(unsigned* bar, volatile LAS unsigned* st) {
    XcdBarrier b; b.bar = bar; b.x = xb_xcc_id(); b.st = st;
    if (threadIdx.x == 0) (void)xb_add(&bar[XB_XCNT(b.x)], 1u);
    return b;
}
DI void xcd_barrier_complete(unsigned* bar, unsigned x, unsigned& nloc, unsigned& nx) {
    const unsigned G = gridDim.x * gridDim.y * gridDim.z;
    unsigned sum, cnt, mine, sp = 0u;
    for (;;) {
        sum = 0u; cnt = 0u; mine = 0u;
#pragma unroll
        for (unsigned j = 0; j < 16; ++j) { const unsigned c = xb_ld(&bar[XB_XCNT(j)]); sum += c; cnt += (c > 0u) ? 1u : 0u; mine = (j == x) ? c : mine; }
        if (sum == G) break;
        __builtin_amdgcn_s_sleep(1);
        if ((++sp & 255u) == 0u) { if (xb_ld(&bar[XB_TMO])) break; if (sp > XB_SPIN_CAP) { atomicAdd(&bar[XB_TMO], 1u); break; } }
    }
    nloc = mine > 0u ? mine : 1u; nx = cnt > 0u ? cnt : 1u;
}
DI void xcd_barrier(const XcdBarrier& b) {
    asm volatile("s_waitcnt vmcnt(0)" ::: "memory");
    __syncthreads();
    if (threadIdx.x == 0) {
        unsigned* bar = b.bar;
        __builtin_amdgcn_s_waitcnt(0);
        unsigned nloc = b.st[0], nx = b.st[1];
        if (nloc == 0u) { xcd_barrier_complete(bar, b.x, nloc, nx); b.st[0] = nloc; b.st[1] = nx; }
        const unsigned old = xb_add(&bar[XB_XSUB(b.x)], 1u);
        const unsigned gen = old / nloc;
        if (old + 1u == (gen + 1u) * nloc) {
            __builtin_amdgcn_fence(__ATOMIC_RELEASE, "agent");
            asm volatile("s_waitcnt vmcnt(0)" ::: "memory");
            const unsigned og = xb_add(&bar[XB_TOP], 1u);
            const unsigned tg = og / nx;
            if (og + 1u == (tg + 1u) * nx) xb_add(&bar[XB_TOPGEN], 1u);
            else XB_SPIN(xb_ld(&bar[XB_TOPGEN]) == tg, bar);
            __builtin_amdgcn_fence(__ATOMIC_ACQUIRE, "agent");
            xb_add(&bar[XB_XGEN(b.x)], 1u);
            asm volatile("s_waitcnt vmcnt(0)" ::: "memory");
        } else {
            XB_SPIN(xb_ld(&bar[XB_XGEN(b.x)]) == gen, bar);
            __builtin_amdgcn_fence(__ATOMIC_ACQUIRE, "agent");
            asm volatile("s_waitcnt vmcnt(0)" ::: "memory");
        }
    }
    __syncthreads();
}

__global__ void __launch_bounds__(512, 2) mega(Args a) {
    extern __shared__ __attribute__((aligned(16))) unsigned char lds_raw[];
    LAS unsigned char* lds = (LAS unsigned char*)lds_raw;
    cg::grid_group grid = cg::this_grid();
    const int G = gridDim.x;
    { volatile LAS unsigned* st0 = (volatile LAS unsigned*)(lds + 131072 + 32); if (threadIdx.x == 0) { st0[0] = 0u; st0[1] = 0u; } __syncthreads(); }
    XcdBarrier xbar = xcd_barrier_post((unsigned*)(a.ws + WS_CTL), (volatile LAS unsigned*)(lds + 131072 + 32));
#define GSYNC() xcd_barrier(xbar)
    bf16_t* P = (bf16_t*)(a.ws + WS_PROJ);
    bf16_t* XB = (bf16_t*)a.out;
    float* V1 = (float*)(a.ws + WS_PROJ);

    if (a.ws == nullptr) grid.sync();
    phase_weights(a, lds, G);
    GSYNC();
    if (PROBE & 1024) { for (int i = 0; i < 20; ++i) GSYNC(); }
    phase_x(a, G);
    GSYNC();
    if (PROBE & 64) { phase_weights(a, lds, G); GSYNC(); phase_x(a, G); GSYNC(); }
    {
        pg8::Gemm g{XB, (const bf16_t*)(a.ws + WS_WIN), T, NP, D, D, D}; pg8::StaticOrder S; S.init(T, NP, G, (int)blockIdx.x);
        EpiBf16S<0> E{P, NP}; pg8::gemm_phase(lds, g, S, E);
        if (PROBE & 1) { GSYNC(); pg8::gemm_phase(lds, g, S, E); }
    }
    GSYNC();
    if (PROBE & 4) { phase_gla_prep(a, lds, G, true); GSYNC(); }
    phase_gla_prep(a, lds, G, false);
    GSYNC();
    {
        const int blk = (int)blockIdx.x, xcd = blk & 7, jx = blk >> 3, q = xcd * 4 + (jx >> 3), seg = q >> 3, stream = (q & 7) * 8 + (jx & 7);
        if (PROBE & 8) { if (seg < 3) phase_gla_scan<false>(a, lds, stream, seg, false); else phase_swa(a, lds, (xcd - 6) * 32 + jx, 64, SWA_A, true);
            GSYNC(); phase_gla_scan<true>(a, lds, stream, seg, true); phase_swa(a, lds, SWA_A + blk, G, 1024, true); GSYNC(); }
        if (PROBE & 16) { if (seg < 3) phase_gla_scan<false>(a, lds, stream, seg, false); GSYNC(); }
        if (PROBE & 256) { phase_gla_scan<true>(a, lds, stream, seg, true); GSYNC(); }
        if (PROBE & 512) { phase_swa(a, lds, blk, G, 1024, true); GSYNC(); }
        if (seg < 3) phase_gla_scan_p1(a, lds, stream, seg); else phase_swa(a, lds, (xcd - 6) * 32 + jx, 64, SWA_A, false);
        GSYNC();
        phase_gla_scan<true>(a, lds, stream, seg, false);
        phase_swa(a, lds, SWA_A + blk, G, 1024, false);
    }
    GSYNC();
    if (PROBE & 32) { phase_gla_norm(a, G, true); GSYNC(); }
    phase_gla_norm(a, G, false);
    GSYNC();
    {
        pg8::Gemm g{P + C_GO, (const bf16_t*)(a.ws + WS_WAB), T, D, 2 * D, NP, 2 * D}; pg8::StaticOrder S; S.init(T, D, G, (int)blockIdx.x);
        EpiMerge E{P}; pg8::gemm_phase(lds, g, S, E);
    }
    GSYNC();
    {
        pg8::Gemm g{P + C_GG, (const bf16_t*)(a.ws + WS_WO), T, D, D, NP, D}; pg8::StaticOrder S; S.init(T, D, G, (int)blockIdx.x);
        EpiResOutBf<false> E{a.x, D, P, NP}; pg8::gemm_phase(lds, g, S, E);
        if (PROBE & 2) { GSYNC(); pg8::gemm_phase(lds, g, S, E); }
    }
    GSYNC();
    if (PROBE & 128) { phase_ln_bf<false>(P, NP, nullptr, 0, P, NP, a.ln1_g, a.ln1_b, G, true, a.ws); GSYNC(); }
    phase_ln_bf<false>(P, NP, nullptr, 0, P, NP, a.ln1_g, a.ln1_b, G, false, a.ws);
    GSYNC();
    {
        pg8::Gemm g{P, (const bf16_t*)(a.ws + WS_WUP), T, DFF, D, NP, D}; pg8::StaticOrder S; S.init(T, DFF, G, (int)blockIdx.x);
        EpiBf16S<1> E{P + C_H, NP}; pg8::gemm_phase(lds, g, S, E);
        if (PROBE & 2) { GSYNC(); pg8::gemm_phase(lds, g, S, E); }
    }
    GSYNC();
    {
        pg8::Gemm g{P + C_H, (const bf16_t*)(a.ws + WS_WDN), T, D, DFF, NP, DFF}; pg8::StaticOrder S; S.init(T, D, G, (int)blockIdx.x);
        EpiResOutBf<true> E{P, NP, P + C_GV, NP}; pg8::gemm_phase(lds, g, S, E);
        if (PROBE & 2) { GSYNC(); pg8::gemm_phase(lds, g, S, E); }
    }
    GSYNC();
    if (PROBE & 128) { phase_ln_bf<true>(P + C_GV, NP, a.out, D, nullptr, 0, a.ln2_g, a.ln2_b, G, true, a.ws); GSYNC(); }
    phase_ln_bf<true>(P + C_GV, NP, a.out, D, nullptr, 0, a.ln2_g, a.ln2_b, G, false, a.ws);
}

extern "C" void kernel_launch(void* const* d_in, const int* in_sizes, int n_in, void* d_out, int out_size, void* d_ws, size_t ws_size, hipStream_t stream) {
    static int grid = 0;
    if (grid == 0) {
        if (n_in != 15 || in_sizes[0] != T * D || out_size != T * D || ws_size < WS_END) { fprintf(stderr, "kernel_launch: unexpected shapes / workspace (%zu)\n", ws_size); grid = -1; return; }
        int dev = 0, cus = 0, per_cu = 0;
        hipGetDevice(&dev); hipDeviceGetAttribute(&cus, hipDeviceAttributeMultiprocessorCount, dev);
        hipFuncSetAttribute((const void*)mega, hipFuncAttributeMaxDynamicSharedMemorySize, LDS_BYTES);
        hipOccupancyMaxActiveBlocksPerMultiprocessor(&per_cu, (const void*)mega, 512, LDS_BYTES);
        if (per_cu < 1) { fprintf(stderr, "kernel_launch: occupancy 0\n"); per_cu = 1; }
        grid = cus;
        if (grid != 256) { fprintf(stderr, "kernel_launch: built for 256 CUs\n"); grid = -1; return; }
    }
    if (grid < 0) return;
    if (hipMemsetAsync((char*)d_ws + WS_CTL, 0, 65536, stream) != hipSuccess) { fprintf(stderr, "kernel_launch: memset failed\n"); return; }
    Args a{};
    a.x = (const float*)d_in[0]; a.w_in = (const float*)d_in[1]; a.w_alpha_up = (const float*)d_in[2]; a.b_alpha = (const float*)d_in[3];
    a.gla_norm_w = (const float*)d_in[4]; a.attn_sinks = (const float*)d_in[5]; a.w_branch_gla = (const float*)d_in[6]; a.w_branch_swa = (const float*)d_in[7];
    a.w_out = (const float*)d_in[8]; a.ln1_g = (const float*)d_in[9]; a.ln1_b = (const float*)d_in[10]; a.w_ff_up = (const float*)d_in[11];
    a.w_ff_down = (const float*)d_in[12]; a.ln2_g = (const float*)d_in[13]; a.ln2_b = (const float*)d_in[14];
    a.out = (float*)d_out; a.ws = (unsigned char*)d_ws;
    void* args[] = {&a};
    hipError_t e = hipLaunchCooperativeKernel((const void*)mega, dim3(grid), dim3(512), args, LDS_BYTES, stream);
    if (e != hipSuccess) fprintf(stderr, "cooperative launch failed: %s (grid %d)\n", hipGetErrorString(e), grid);
}
```
